# Optimizing an MI355X kernel written in HIP

```python
import math
import jax, jax.numpy as jnp
from jax import lax
import numpy as np

D_MODEL = 1024
BATCH = 8
SEQ = 4096
DEPTH = 2

HEAD_DIM = 64
N_HEADS = 4
MIX_WIDTH = N_HEADS * HEAD_DIM
N_MIXERS = 4
ROPE_THETA = 500000.0
ROPE_FRACTION_DEN = 4
Q_BLOCK = 128
SPARSE_Q_BLOCK = 32
DIFF_DIM = HEAD_DIM // 2
MOBA_BLOCK = 256
MOBA_TOPK = 3
NSA_CMP_LEN = 32
NSA_CMP_STRIDE = 16
NSA_SLC_BLOCK = 64
NSA_TOPN = 16
NSA_WINDOW = 512
NSA_KV_DIM = HEAD_DIM
FFN_HIDDEN = -(-8 * D_MODEL // (3 * 256)) * 256
NEG_INF = -1e30
BIG = 1e30
RMS_EPS = 1e-6
IN_SPLITS = (MIX_WIDTH,) * 10 + (NSA_KV_DIM,) * 6 + (3 * N_HEADS,)
IN_COLS = sum(IN_SPLITS)

kernel_name = "hybrid_gated_sparse_attention_trunk"


def _rms_norm(x, g):
    xf = x.astype(jnp.float32)
    y = xf * lax.rsqrt(jnp.mean(xf * xf, axis=-1, keepdims=True) + RMS_EPS)
    return (y * g.astype(jnp.float32)).astype(x.dtype)


def _rope(x, pos):
    d = x.shape[-1]
    r = d // ROPE_FRACTION_DEN
    half = r // 2
    inv = ROPE_THETA ** (-jnp.arange(half, dtype=jnp.float32) * 2.0 / r)
    ang = pos.astype(jnp.float32)[:, None] * inv[None, :]
    cos, sin = jnp.cos(ang), jnp.sin(ang)
    xf = x.astype(jnp.float32)
    x1, x2 = xf[..., :half], xf[..., half:r]
    out = jnp.concatenate([x1 * cos - x2 * sin, x2 * cos + x1 * sin, xf[..., r:]], axis=-1)
    return out.astype(x.dtype)


def _heads(t):
    b, s, _ = t.shape
    return t.reshape(b, s, N_HEADS, -1).transpose(0, 2, 1, 3)


def _merge_heads(o):
    b, h, s, d = o.shape
    return o.transpose(0, 2, 1, 3).reshape(b, s, h * d)


def _masked_softmax(s, mask):
    s = jnp.where(mask, s.astype(jnp.float32), NEG_INF)
    m = jnp.max(s, axis=-1, keepdims=True)
    e = jnp.where(mask, jnp.exp(s - m), 0.0)
    return e / jnp.maximum(jnp.sum(e, axis=-1, keepdims=True), 1e-30)


def _sweep(fn, seq, blk):
    return lax.map(fn, jnp.arange(seq // blk, dtype=jnp.int32) * blk)


def _unblock(y):
    n, b, h, c, d = y.shape
    return jnp.transpose(y, (1, 2, 0, 3, 4)).reshape(b, h, n * c, d)


def _stick_breaking(q, k, v):
    b, h, s, d = q.shape
    scale = 1.0 / math.sqrt(d)
    kpos = jnp.arange(s, dtype=jnp.int32)

    def blk(c0):
        qb = lax.dynamic_slice_in_dim(q, c0, Q_BLOCK, axis=2)
        z = jnp.einsum('bhqd,bhkd->bhqk', qb, k).astype(jnp.float32) * scale
        qpos = c0 + jnp.arange(Q_BLOCK, dtype=jnp.int32)
        mask = kpos[None, :] < qpos[:, None]
        log1m = jnp.where(mask, jax.nn.log_sigmoid(-z), 0.0)
        between = lax.cumsum(log1m, axis=3, reverse=True) - log1m
        a = jnp.where(mask, jnp.exp(jax.nn.log_sigmoid(z) + between), 0.0)
        return jnp.einsum('bhqk,bhkd->bhqd', a.astype(v.dtype), v)

    return _unblock(_sweep(blk, s, Q_BLOCK))


def _diff_attention(q1, q2, k1, k2, v, lam):
    b, h, s, d = q1.shape
    scale = 1.0 / math.sqrt(d)
    kpos = jnp.arange(s, dtype=jnp.int32)

    def blk(c0):
        qpos = c0 + jnp.arange(Q_BLOCK, dtype=jnp.int32)
        mask = kpos[None, :] <= qpos[:, None]
        q1b = lax.dynamic_slice_in_dim(q1, c0, Q_BLOCK, axis=2)
        q2b = lax.dynamic_slice_in_dim(q2, c0, Q_BLOCK, axis=2)
        p1 = _masked_softmax(jnp.einsum('bhqd,bhkd->bhqk', q1b, k1).astype(jnp.float32) * scale, mask)
        p2 = _masked_softmax(jnp.einsum('bhqd,bhkd->bhqk', q2b, k2).astype(jnp.float32) * scale, mask)
        p = p1 - lam * p2
        return jnp.einsum('bhqk,bhkd->bhqd', p.astype(v.dtype), v)

    return _unblock(_sweep(blk, s, Q_BLOCK))


def _moba(q, k, v):
    b, h, s, d = q.shape
    scale = 1.0 / math.sqrt(d)
    nb = -(-s // MOBA_BLOCK)
    pad = nb * MOBA_BLOCK - s
    kb = jnp.pad(k, ((0, 0), (0, 0), (0, pad), (0, 0))).reshape(b, h, nb, MOBA_BLOCK, d)
    vb = jnp.pad(v, ((0, 0), (0, 0), (0, pad), (0, 0))).reshape(b, h, nb, MOBA_BLOCK, d)
    kmean = jnp.mean(kb.astype(jnp.float32), axis=3).astype(k.dtype)
    ksel = min(MOBA_TOPK, nb - 1)
    bi = jnp.arange(b)[:, None, None, None]
    hi = jnp.arange(h)[None, :, None, None]
    blk_ids = jnp.arange(nb, dtype=jnp.int32)
    off = jnp.arange(MOBA_BLOCK, dtype=jnp.int32)
    L = MOBA_BLOCK
    C = SPARSE_Q_BLOCK

    def blk(c0):
        qb = lax.dynamic_slice_in_dim(q, c0, C, axis=2)
        qpos = c0 + jnp.arange(C, dtype=jnp.int32)
        ob = c0 // MOBA_BLOCK
        k_own = lax.dynamic_index_in_dim(kb, ob, axis=2, keepdims=False)
        v_own = lax.dynamic_index_in_dim(vb, ob, axis=2, keepdims=False)
        s_own = jnp.einsum('bhqd,bhkd->bhqk', qb, k_own).astype(jnp.float32) * scale
        m_own = jnp.broadcast_to((ob * MOBA_BLOCK + off)[None, :] <= qpos[:, None], s_own.shape)
        if ksel == 0:
            p_own = _masked_softmax(s_own, m_own).astype(v.dtype)
            return jnp.einsum('bhqk,bhkd->bhqd', p_own, v_own)
        gate = jnp.einsum('bhqd,bhnd->bhqn', qb, kmean).astype(jnp.float32)
        gate = jnp.where(blk_ids < ob, gate, NEG_INF)
        _, idx = lax.top_k(gate, ksel)
        valid = idx < ob
        k_sel = kb[bi, hi, idx]
        v_sel = vb[bi, hi, idx]
        s_sel = jnp.einsum('bhqd,bhqnkd->bhqnk', qb, k_sel).astype(jnp.float32) * scale
        m_sel = jnp.broadcast_to(valid[..., None], s_sel.shape)
        sc = jnp.concatenate([s_sel.reshape(b, h, C, ksel * L), s_own], axis=-1)
        mk = jnp.concatenate([m_sel.reshape(b, h, C, ksel * L), m_own], axis=-1)
        p = _masked_softmax(sc, mk).astype(v.dtype)
        p_sel = p[..., :ksel * L].reshape(b, h, C, ksel, L)
        p_own = p[..., ksel * L:]
        return (jnp.einsum('bhqnk,bhqnkd->bhqd', p_sel, v_sel)
                + jnp.einsum('bhqk,bhkd->bhqd', p_own, v_own))

    return _unblock(_sweep(blk, s, C))


def _nsa(q, kc_tok, vc_tok, ks, vs, kw, vw, gates, kn_g, cmp_pe, cmp_w):
    b, h, s, d = q.shape
    scale = 1.0 / math.sqrt(d)
    pos = jnp.arange(s, dtype=jnp.int32)
    C = SPARSE_Q_BLOCK
    nc = (s - NSA_CMP_LEN) // NSA_CMP_STRIDE + 1
    cstart = NSA_CMP_STRIDE * jnp.arange(nc, dtype=jnp.int32)
    widx = cstart[:, None] + jnp.arange(NSA_CMP_LEN, dtype=jnp.int32)[None, :]
    cmp_end = cstart + (NSA_CMP_LEN - 1)

    def compress(t, pe, w):
        blocks = t[:, widx] + pe
        return blocks.reshape(b, nc, NSA_CMP_LEN * d) @ w

    kc = _rope(_rms_norm(compress(kc_tok, cmp_pe[0], cmp_w[0]), kn_g[0]), cmp_end)
    vc = compress(vc_tok, cmp_pe[1], cmp_w[1])
    ns = s // NSA_SLC_BLOCK
    ntop = min(NSA_TOPN, ns)
    ks = _rope(_rms_norm(ks, kn_g[1]), pos)
    ksb = ks.reshape(b, ns, NSA_SLC_BLOCK, d)
    vsb = vs.reshape(b, ns, NSA_SLC_BLOCK, d)
    sstart = NSA_SLC_BLOCK * jnp.arange(ns, dtype=jnp.int32)
    overlap = jnp.clip(jnp.minimum(cstart[:, None] + NSA_CMP_LEN, sstart[None, :] + NSA_SLC_BLOCK)
                       - jnp.maximum(cstart[:, None], sstart[None, :]), 0, None)
    cmp_to_slc = overlap.astype(jnp.float32) / NSA_CMP_STRIDE
    slc_ids = jnp.arange(ns, dtype=jnp.int32)
    slc_off = jnp.arange(NSA_SLC_BLOCK, dtype=jnp.int32)
    bi = jnp.arange(b)[:, None, None]
    kw = _rope(_rms_norm(kw, kn_g[2]), pos)
    kw_pad = jnp.pad(kw, ((0, 0), (NSA_WINDOW, 0), (0, 0)))
    vw_pad = jnp.pad(vw, ((0, 0), (NSA_WINDOW, 0), (0, 0)))
    woff = jnp.arange(NSA_WINDOW + C, dtype=jnp.int32)

    def blk(c0):
        qb = lax.dynamic_slice_in_dim(q, c0, C, axis=2)
        qpos = c0 + jnp.arange(C, dtype=jnp.int32)
        s_c = jnp.einsum('bhqd,bnd->bhqn', qb, kc).astype(jnp.float32) * scale
        p_c = _masked_softmax(s_c, cmp_end[None, :] <= qpos[:, None])
        o_c = jnp.einsum('bhqn,bnd->bhqd', p_c.astype(vc.dtype), vc)
        imp = jnp.einsum('bhqn,nj->bqj', p_c, cmp_to_slc)
        cur = qpos // NSA_SLC_BLOCK
        forced = ((slc_ids[None, :] == 0) | (slc_ids[None, :] == cur[:, None])
                  | (slc_ids[None, :] == cur[:, None] - 1))
        allowed = slc_ids[None, :] <= cur[:, None]
        score = jnp.where(allowed, jnp.where(forced, BIG, imp), NEG_INF)
        _, idx = lax.top_k(score, ntop)
        k_sel = ksb[bi, idx]
        v_sel = vsb[bi, idx]
        kpos_sel = idx[..., None] * NSA_SLC_BLOCK + slc_off
        m_s = (kpos_sel <= qpos[None, :, None, None]).reshape(b, 1, C, ntop * NSA_SLC_BLOCK)
        s_s = jnp.einsum('bhqd,bqnkd->bhqnk', qb, k_sel).astype(jnp.float32) * scale
        p_s = _masked_softmax(s_s.reshape(b, h, C, ntop * NSA_SLC_BLOCK), m_s)
        p_s = p_s.reshape(b, h, C, ntop, NSA_SLC_BLOCK).astype(v_sel.dtype)
        o_s = jnp.einsum('bhqnk,bqnkd->bhqd', p_s, v_sel)
        kwb = lax.dynamic_slice_in_dim(kw_pad, c0, NSA_WINDOW + C, axis=1)
        vwb = lax.dynamic_slice_in_dim(vw_pad, c0, NSA_WINDOW + C, axis=1)
        kp = c0 - NSA_WINDOW + woff
        m_w = ((kp[None, :] <= qpos[:, None]) & (kp[None, :] > qpos[:, None] - NSA_WINDOW)
               & (kp[None, :] >= 0))
        s_w = jnp.einsum('bhqd,bkd->bhqk', qb, kwb).astype(jnp.float32) * scale
        o_w = jnp.einsum('bhqk,bkd->bhqd', _masked_softmax(s_w, m_w).astype(vwb.dtype), vwb)
        return (o_c, o_s, o_w)

    o_c, o_s, o_w = _sweep(blk, s, C)
    return gates[0] * _unblock(o_c) + gates[1] * _unblock(o_s) + gates[2] * _unblock(o_w)


def setup_inputs(seed: int = 0) -> dict:
    key = jax.random.key(seed)
    ks = jax.random.split(key, 21)
    D, L = D_MODEL, DEPTH

    def nrm(k, shape, scale):
        return jax.random.normal(k, shape, jnp.float32) * scale

    def gain(k, shape):
        return 1.0 + nrm(k, shape, 0.05)

    return {
        "x": nrm(ks[0], (BATCH, SEQ, D), 1.0),
        "attn_norm_g": gain(ks[1], (L, D)),
        "w_in": nrm(ks[2], (L, D, IN_COLS), D ** -0.5),
        "diff_qn_g": gain(ks[3], (L, DIFF_DIM)),
        "diff_kn_g": gain(ks[4], (L, DIFF_DIM)),
        "diff_lam": nrm(ks[5], (L, 4, DIFF_DIM), 0.1),
        "diff_subln_g": gain(ks[6], (L, HEAD_DIM)),
        "moba_qn_g": gain(ks[7], (L, HEAD_DIM)),
        "moba_kn_g": gain(ks[8], (L, HEAD_DIM)),
        "nsa_qn_g": gain(ks[9], (L, HEAD_DIM)),
        "nsa_kn_g": gain(ks[10], (L, 3, NSA_KV_DIM)),
        "nsa_cmp_pe": nrm(ks[11], (L, 2, NSA_CMP_LEN, NSA_KV_DIM), 0.1),
        "nsa_cmp_w": nrm(ks[12], (L, 2, NSA_CMP_LEN * NSA_KV_DIM, NSA_KV_DIM), (NSA_CMP_LEN * NSA_KV_DIM) ** -0.5),
        "w_gate": nrm(ks[13], (L, N_MIXERS, D, D), D ** -0.5),
        "b_gate": nrm(ks[14], (L, N_MIXERS, D), 0.01),
        "w_branch": nrm(ks[15], (L, N_MIXERS, MIX_WIDTH, D), MIX_WIDTH ** -0.5),
        "w_out": nrm(ks[16], (L, D, D), D ** -0.5),
        "ffn_norm_g": gain(ks[17], (L, D)),
        "w_ffn_gate": nrm(ks[18], (L, D, FFN_HIDDEN), D ** -0.5),
        "w_ffn_up": nrm(ks[19], (L, D, FFN_HIDDEN), D ** -0.5),
        "w_ffn_down": nrm(ks[20], (L, FFN_HIDDEN, D), FFN_HIDDEN ** -0.5),
    }


def reference(x, attn_norm_g, w_in, diff_qn_g, diff_kn_g, diff_lam, diff_subln_g,
              moba_qn_g, moba_kn_g, nsa_qn_g, nsa_kn_g, nsa_cmp_pe, nsa_cmp_w,
              w_gate, b_gate, w_branch, w_out, ffn_norm_g, w_ffn_gate, w_ffn_up, w_ffn_down):
    b, s, _ = x.shape
    pos = jnp.arange(s, dtype=jnp.int32)
    split_at = [int(o) for o in np.cumsum(IN_SPLITS)[:-1]]
    for l in range(DEPTH):
        xn = _rms_norm(x, attn_norm_g[l])
        (sb_q, sb_k, sb_v, df_q, df_k, df_v, mb_q, mb_k, mb_v, ns_q,
         ns_kc, ns_vc, ns_ks, ns_vs, ns_kw, ns_vw, ns_g) = jnp.split(xn @ w_in[l], split_at, axis=-1)

        o_a = _stick_breaking(_heads(sb_q), _heads(sb_k), _heads(sb_v))

        lam_init = 0.8 - 0.6 * math.exp(-0.3 * l)
        dq = df_q.reshape(b, s, N_HEADS, 2, DIFF_DIM).transpose(3, 0, 2, 1, 4)
        dk = df_k.reshape(b, s, N_HEADS, 2, DIFF_DIM).transpose(3, 0, 2, 1, 4)
        dq = _rope(_rms_norm(dq, diff_qn_g[l]), pos)
        dk = _rope(_rms_norm(dk, diff_kn_g[l]), pos)
        lp = diff_lam[l].astype(jnp.float32)
        lam = jnp.exp(jnp.sum(lp[0] * lp[1])) - jnp.exp(jnp.sum(lp[2] * lp[3])) + lam_init
        o_b = _diff_attention(dq[0], dq[1], dk[0], dk[1], _heads(df_v), lam)
        o_b = _rms_norm(o_b, diff_subln_g[l]) * (1.0 - lam_init)

        mq = _rope(_rms_norm(_heads(mb_q), moba_qn_g[l]), pos)
        mk = _rope(_rms_norm(_heads(mb_k), moba_kn_g[l]), pos)
        o_c = _moba(mq, mk, _heads(mb_v))

        nq = _rope(_rms_norm(_heads(ns_q), nsa_qn_g[l]), pos)
        g_nsa = jax.nn.sigmoid(ns_g).reshape(b, s, 3, N_HEADS).transpose(2, 0, 3, 1)[..., None]
        o_d = _nsa(nq, ns_kc, ns_vc, ns_ks, ns_vs, ns_kw, ns_vw, g_nsa,
                   nsa_kn_g[l], nsa_cmp_pe[l], nsa_cmp_w[l])

        merged = None
        for i, o in enumerate((o_a, o_b, o_c, o_d)):
            g = jax.nn.sigmoid(xn @ w_gate[l, i] + b_gate[l, i])
            term = g * (_merge_heads(o) @ w_branch[l, i])
            merged = term if merged is None else merged + term
        x = x + merged @ w_out[l]

        hn = _rms_norm(x, ffn_norm_g[l])
        x = x + (jax.nn.silu(hn @ w_ffn_gate[l]) * (hn @ w_ffn_up[l])) @ w_ffn_down[l]
    return x
```

```cpp
#include <hip/hip_runtime.h>
#include <hip/hip_cooperative_groups.h>
#include <cstdio>
#include <cstdint>
namespace cg = cooperative_groups;
#define PG8_LAS __attribute__((address_space(3)))
#define LAS __attribute__((address_space(3)))
#define DI __device__ __forceinline__
#ifndef GEMM_SEL
#define GEMM_SEL 0xffu
#endif
#ifndef LB2
#define LB2
#endif
#ifndef PH_MASK
#define PH_MASK 0xffffffffu
#endif
__device__ __forceinline__ int fresh_lane() { int l; asm volatile("v_mbcnt_lo_u32_b32 %0, -1, 0\n\tv_mbcnt_hi_u32_b32 %0, -1, %0" : "=v"(l)); return l; }
#ifndef DIFF_MERGED
#define DIFF_MERGED 0
#endif
#ifndef PIPE64
#define PIPE64 1
#endif
namespace pg8 {
typedef unsigned short bf16_t;
typedef short bf16x8 __attribute__((ext_vector_type(8)));
typedef float f32x4 __attribute__((ext_vector_type(4)));
typedef unsigned u32x4 __attribute__((ext_vector_type(4)));
constexpr int BM = 256, BK = 64, HALF = 128, HTB = HALF * BK * 2  , STAGE_BYTES = 8 * HTB, NXCD = 8, WGM = 8;

__host__ __device__ __forceinline__ int lds_byte(int r, int c) { const int st = (r >> 4) * 2 + (c >> 5), rr = r & 15, cc = c & 31, ob = rr * 64 + cc * 2; return st * 1024 + (ob ^ (((ob >> 9) & 1) << 5)); }
__host__ __device__ __forceinline__ void stage_rc(int b, int& R, int& C) { const int st = b / 1024, sb = b % 1024, swz = sb ^ (((sb >> 9) & 1) << 5); R = (st >> 1) * 16 + swz / 64; C = (st & 1) * 32 + (swz % 64) / 2; }
__host__ __device__ __forceinline__ int perm32(int rho) { const int n = rho >> 4, i = rho & 15; return 8 * (i >> 2) + 4 * n + (i & 3); }

struct Unit { int pm, pn; };
struct Gemm { const bf16_t* A; const bf16_t* Bt; int M, N, K; };

struct StaticOrder {
    int nM, nN, nwg, G, c;
    __host__ __device__ void init(int M, int N, int G_, int c_) { nM = M / BM; nN = N / BM; nwg = nM * nN; G = G_; c = c_; }
    __host__ __device__ bool next(int i, Unit& u) const {
        const long L = (long)i * G + c; if (L >= nwg) return false;
        int wgid = (int)L; { const int q = nwg / NXCD, r = nwg % NXCD, xcd = wgid % NXCD, off = wgid / NXCD; wgid = (xcd < r ? xcd * (q + 1) : r * (q + 1) + (xcd - r) * q) + off; }
        const int nig = WGM * nN, gid = wgid / nig, fm = gid * WGM, gsz = (nM - fm) < WGM ? (nM - fm) : WGM;
        u.pm = fm + ((wgid % nig) % gsz); u.pn = (wgid % nig) / gsz; return true;
    }
    __device__ __forceinline__ void a_ready(const Unit&) const {}
    __device__ __forceinline__ void done(const Unit&) const {}
};
__device__ __forceinline__ unsigned cvt_pk_bf16(float lo, float hi) { unsigned r; asm volatile("v_cvt_pk_bf16_f32 %0, %1, %2" : "=v"(r) : "v"(lo), "v"(hi)); return r; }
template <class Epi, class Sched, bool ALIGN_EPI = false, bool SP2 = false>
__device__ __forceinline__ void gemm_phase(PG8_LAS unsigned char* lds, const Gemm g, const Sched& S, const Epi& E, const int wave_s) {
    int tid_ = wave_s * 64 + fresh_lane();
    const int tid = tid_, wid = __builtin_amdgcn_readfirstlane(tid >> 6), lane = tid & 63, wr = wid >> 2, wc = wid & 3, fr = lane & 15, fq = lane >> 4;
    int K_ = g.K; asm volatile("" : "+s"(K_));
    const int K = K_, nt = K / BK;
    unsigned voffA[2], voffB[2];
#pragma unroll
    for (int i = 0; i < 2; ++i) { int R, C; stage_rc(tid * 16 + i * 8192, R, C); const int Rb = Epi::PERM ? ((R & ~31) + perm32(R & 31)) : R;
        voffA[i] = (unsigned)(R * K + C) * 2u; voffB[i] = (unsigned)(Rb * K + C) * 2u; }
    const size_t kstep = (size_t)(BK * 2);
    const size_t hstep = (size_t)HALF * K * 2;
    const size_t tstep = 2 * hstep;
    const unsigned ldsw = (unsigned)wid * 1024u;
    const int aoff = lds_byte(wr * 64 + fr, fq * 8), boff = lds_byte(wc * 32 + fr, fq * 8);
#define PG8_SA(b, h) (((b) * 2 + (h)) * HTB)
#define PG8_SB(b, h) ((4 + (b) * 2 + (h)) * HTB)
#define PG8_STAGE(bufoff, gbase, voff) do { _Pragma("unroll") for (int _i = 0; _i < 2; ++_i) \
        __builtin_amdgcn_global_load_lds((const unsigned*)((const char*)(gbase) + (voff)[_i]), (PG8_LAS unsigned*)(lds + (bufoff) + ldsw + _i * 8192), 16, 0, 0); } while (0)
#define PG8_LDA(dst, b, h) do { _Pragma("unroll") for (int m = 0; m < 4; ++m) _Pragma("unroll") for (int k = 0; k < 2; ++k) dst[m][k] = *(const PG8_LAS bf16x8*)(lds + PG8_SA(b, h) + aoff + m * 2048 + k * 1024); } while (0)
#define PG8_LDB(dst, b, h) do { _Pragma("unroll") for (int n = 0; n < 2; ++n) _Pragma("unroll") for (int k = 0; k < 2; ++k) dst[n][k] = *(const PG8_LAS bf16x8*)(lds + PG8_SB(b, h) + boff + n * 2048 + k * 1024); } while (0)
#define PG8_MMA(ai, bj, At, Bt) do { __builtin_amdgcn_s_setprio(1); _Pragma("unroll") for (int m = 0; m < 4; ++m) _Pragma("unroll") for (int n = 0; n < 2; ++n) _Pragma("unroll") for (int k = 0; k < 2; ++k) \
        acc[ai][bj][m][n] = __builtin_amdgcn_mfma_f32_16x16x32_bf16(Bt[n][k], At[m][k], acc[ai][bj][m][n], 0, 0, 0); __builtin_amdgcn_s_setprio(0); } while (0)
#define PG8_WAIT_V(n) asm volatile("s_waitcnt vmcnt(" #n ")" ::: "memory")
#define PG8_WAIT_L(n) asm volatile("s_waitcnt lgkmcnt(" #n ")" ::: "memory")
#define PG8_BAR __builtin_amdgcn_s_barrier()
#define PG8_SCHED __builtin_amdgcn_sched_barrier(0)
    Unit cur, nxt; int ui = 0;
    if (!S.next(0, cur)) return;
    f32x4 acc[2][2][4][2];
#pragma unroll
    for (int a = 0; a < 2; ++a)
#pragma unroll
        for (int b = 0; b < 2; ++b)
#pragma unroll
            for (int m = 0; m < 4; ++m)
#pragma unroll
                for (int n = 0; n < 2; ++n) acc[a][b][m][n] = (f32x4){0.f, 0.f, 0.f, 0.f};
    bf16x8 At[4][2], B0[2][2], B1[2][2];
    const char* cA = (const char*)g.A + (size_t)cur.pm * tstep; const char* cB = (const char*)g.Bt + (size_t)cur.pn * tstep;
    S.a_ready(cur);
    if constexpr (SP2) {
        PG8_STAGE(PG8_SB(0, 0), cB, voffB); PG8_STAGE(PG8_SB(0, 1), cB + hstep, voffB); PG8_STAGE(PG8_SA(0, 0), cA, voffA); PG8_STAGE(PG8_SA(0, 1), cA + hstep, voffA);
        if (wr == 1) PG8_BAR;
        PG8_WAIT_V(2); PG8_BAR;
        PG8_STAGE(PG8_SB(1, 0), cB + kstep, voffB); PG8_STAGE(PG8_SA(1, 0), cA + kstep, voffA); PG8_STAGE(PG8_SB(1, 1), cB + hstep + kstep, voffB);
        PG8_WAIT_V(6); PG8_BAR;
    } else {
        PG8_STAGE(PG8_SB(0, 0), cB, voffB); PG8_STAGE(PG8_SA(0, 0), cA, voffA); PG8_STAGE(PG8_SB(0, 1), cB + hstep, voffB); PG8_STAGE(PG8_SA(0, 1), cA + hstep, voffA);
        if (wr == 1) PG8_BAR;
        PG8_WAIT_V(4); PG8_BAR;
        PG8_STAGE(PG8_SB(1, 0), cB + kstep, voffB); PG8_STAGE(PG8_SA(1, 0), cA + kstep, voffA); PG8_STAGE(PG8_SB(1, 1), cB + hstep + kstep, voffB);
        PG8_WAIT_V(6); PG8_BAR;
    }
    for (;;) {
        const bool has_next = S.next(ui + 1, nxt);
        const char* nA = has_next ? (const char*)g.A + (size_t)nxt.pm * tstep : cA; const char* nB = has_next ? (const char*)g.Bt + (size_t)nxt.pn * tstep : cB;
        for (int t = 0; t < nt; t += 2) {
            const bool last = (t == nt - 2);
            const char* a1 = cA + (size_t)(t + 1) * kstep;
            const char* a2 = last ? nA : cA + (size_t)(t + 2) * kstep; const char* b2 = last ? nB : cB + (size_t)(t + 2) * kstep;
            const char* a3 = a2 + kstep; const char* b3 = b2 + kstep;
            if (last && has_next) S.a_ready(nxt);
            if constexpr (SP2) {
            PG8_LDB(B0, 0, 0); PG8_LDB(B1, 0, 1); PG8_SCHED; PG8_LDA(At, 0, 0); PG8_STAGE(PG8_SA(1, 1), a1 + hstep, voffA);
            PG8_WAIT_V(8); PG8_WAIT_L(0); PG8_BAR; PG8_MMA(0, 0, At, B0); PG8_MMA(0, 1, At, B1); PG8_BAR; PG8_SCHED;
            PG8_LDA(At, 0, 1); PG8_STAGE(PG8_SB(0, 0), b2, voffB); PG8_STAGE(PG8_SB(0, 1), b2 + hstep, voffB); PG8_STAGE(PG8_SA(0, 0), a2, voffA);
            PG8_WAIT_V(8); PG8_WAIT_L(0); PG8_BAR; PG8_MMA(1, 0, At, B0); PG8_MMA(1, 1, At, B1); PG8_BAR; PG8_SCHED;
            PG8_LDB(B0, 1, 0); PG8_LDB(B1, 1, 1); PG8_SCHED; PG8_LDA(At, 1, 0); PG8_STAGE(PG8_SA(0, 1), a2 + hstep, voffA);
            PG8_WAIT_V(8); PG8_WAIT_L(0); PG8_BAR; PG8_MMA(0, 0, At, B0); PG8_MMA(0, 1, At, B1); PG8_BAR; PG8_SCHED;
            PG8_LDA(At, 1, 1); PG8_STAGE(PG8_SB(1, 0), b3, voffB); PG8_STAGE(PG8_SB(1, 1), b3 + hstep, voffB); PG8_STAGE(PG8_SA(1, 0), a3, voffA);
            PG8_WAIT_V(8); PG8_WAIT_L(0); PG8_BAR; PG8_MMA(1, 0, At, B0); PG8_MMA(1, 1, At, B1); PG8_BAR; PG8_SCHED;
            } else {
            PG8_LDB(B0, 0, 0); PG8_SCHED; PG8_LDA(At, 0, 0); PG8_STAGE(PG8_SA(1, 1), a1 + hstep, voffA);
            PG8_WAIT_L(8); PG8_BAR; PG8_WAIT_L(0); PG8_MMA(0, 0, At, B0); PG8_BAR; PG8_SCHED;
            PG8_LDB(B1, 0, 1); PG8_STAGE(PG8_SB(0, 0), b2, voffB);
            PG8_BAR; PG8_WAIT_L(0); PG8_MMA(0, 1, At, B1); PG8_BAR;
            PG8_LDA(At, 0, 1); PG8_STAGE(PG8_SA(0, 0), a2, voffA);
            PG8_BAR; PG8_WAIT_L(0); PG8_MMA(1, 0, At, B0); PG8_BAR; PG8_SCHED;
            PG8_STAGE(PG8_SB(0, 1), b2 + hstep, voffB);
            PG8_WAIT_V(6); PG8_BAR; PG8_MMA(1, 1, At, B1); PG8_BAR;
            PG8_LDB(B0, 1, 0); PG8_SCHED; PG8_LDA(At, 1, 0); PG8_STAGE(PG8_SA(0, 1), a2 + hstep, voffA);
            PG8_WAIT_L(8); PG8_BAR; PG8_WAIT_L(0); PG8_MMA(0, 0, At, B0); PG8_BAR; PG8_SCHED;
            PG8_LDB(B1, 1, 1); PG8_STAGE(PG8_SB(1, 0), b3, voffB);
            PG8_BAR; PG8_WAIT_L(0); PG8_MMA(0, 1, At, B1); PG8_BAR;
            PG8_LDA(At, 1, 1); PG8_STAGE(PG8_SA(1, 0), a3, voffA);
            PG8_BAR; PG8_WAIT_L(0); PG8_MMA(1, 0, At, B0); PG8_BAR; PG8_SCHED;
            PG8_STAGE(PG8_SB(1, 1), b3 + hstep, voffB);
            PG8_WAIT_V(6); PG8_BAR; PG8_MMA(1, 1, At, B1); PG8_BAR;
            }
        }
        if constexpr (ALIGN_EPI) { if (wr == 0) PG8_BAR; }
        if constexpr (!Epi::AFTER_DRAIN) { E(acc, cur, wr, wc, fr, fq); S.done(cur); }
        if (!has_next) break;
#pragma unroll
        for (int a = 0; a < 2; ++a)
#pragma unroll
            for (int b = 0; b < 2; ++b)
#pragma unroll
                for (int m = 0; m < 4; ++m)
#pragma unroll
                    for (int n = 0; n < 2; ++n) acc[a][b][m][n] = (f32x4){0.f, 0.f, 0.f, 0.f};
        cur = nxt; cA = nA; cB = nB; ++ui;
        if constexpr (ALIGN_EPI) { if (wr == 1) PG8_BAR; }
    }
    PG8_WAIT_V(0);
    if constexpr (!ALIGN_EPI) { if (wr == 0) PG8_BAR; }
    PG8_BAR;
    if constexpr (Epi::AFTER_DRAIN) { E.fused(acc, cur, wr, wc, fr, fq, lds, wid, lane); S.done(cur); }
#undef PG8_SA
#undef PG8_SB
#undef PG8_STAGE
#undef PG8_LDA
#undef PG8_LDB
#undef PG8_MMA
#undef PG8_WAIT_V
#undef PG8_WAIT_L
#undef PG8_BAR
#undef PG8_SCHED
}
}
typedef unsigned short bf16_t;
typedef short bf16x8 __attribute__((ext_vector_type(8)));
typedef short s16x4 __attribute__((ext_vector_type(4)));
typedef float f32x4 __attribute__((ext_vector_type(4)));
typedef float f32x16 __attribute__((ext_vector_type(16)));
typedef unsigned u32x4 __attribute__((ext_vector_type(4)));
typedef unsigned u32x2 __attribute__((ext_vector_type(2)));
typedef float f32x2_t __attribute__((ext_vector_type(2)));
typedef __bf16 bf16x2_t __attribute__((ext_vector_type(2)));

constexpr int NB = 8, SEQ = 4096, TOK = NB * SEQ, DM = 1024, NIN = 3072, INC = 2956, FF = 2816, NGU = 5632, DEPTH = 2;
constexpr int C_SBQ = 0, C_SBK = 256, C_SBV = 512, C_DFQ = 768, C_DFK = 1024, C_DFV = 1280, C_MBQ = 1536, C_MBK = 1792, C_MBV = 2048,
              C_NSQ = 2304, C_KC = 2560, C_VC = 2624, C_KS = 2688, C_VS = 2752, C_KW = 2816, C_VW = 2880, C_NSG = 2944;
constexpr size_t MiB = 1u << 20;
constexpr size_t WS_KMEAN = 71 * MiB, WS_KC = 262144, WS_VC = 524288, WS_CWT = 1 * MiB, WS_W = 2 * MiB;
constexpr size_t WL_IN = 0, WL_G = 6 * MiB, WL_B = 14 * MiB, WL_O = 16 * MiB, WL_GU = 18 * MiB, WL_D = 29 * MiB, WL_STRIDE = 34 * MiB + 512 * 1024;
constexpr size_t WS_XN = 72 * MiB, WS_O = 136 * MiB, WS_H = 200 * MiB, WS_X1 = 200 * MiB, WS_T = 200 * MiB, WS_A = 328 * MiB, WS_END = 504 * MiB;
constexpr int LDS_BYTES = 147456;
constexpr int NWAVES = 8;
constexpr float RMS_EPS = 1e-6f;

DI unsigned cvtpk(float lo, float hi) { f32x2_t v = {lo, hi}; bf16x2_t b = __builtin_convertvector(v, bf16x2_t); return __builtin_bit_cast(unsigned, b); }
DI float bf2f(unsigned short u) { return __builtin_bit_cast(float, (unsigned)u << 16); }
DI float bflo(unsigned u) { return __builtin_bit_cast(float, u << 16); }
DI float bfhi(unsigned u) { return __builtin_bit_cast(float, u & 0xffff0000u); }
DI float sigmoidf_(float x) { return __builtin_amdgcn_rcpf(1.0f + __builtin_amdgcn_exp2f(x * -1.4426950408889634f)); }


DI float shx(float v, int m, int lane) { return __builtin_bit_cast(float, __builtin_amdgcn_ds_bpermute((lane ^ m) << 2, __builtin_bit_cast(int, v))); }
DI unsigned shxu(unsigned v, int m, int lane) { return (unsigned)__builtin_amdgcn_ds_bpermute((lane ^ m) << 2, (int)v); }
DI float shx32(float v, int lane) {
    const unsigned u = __builtin_bit_cast(unsigned, v); auto rr = __builtin_amdgcn_permlane32_swap(u, u, false, false);
    return __builtin_bit_cast(float, (lane & 32) ? rr[0] : rr[1]); }

namespace pg8 {
struct EpiStore {
    static constexpr bool PERM = true, AFTER_DRAIN = false;
    bf16_t* O; int ldc;
    DI void operator()(const f32x4 (&acc)[2][2][4][2], const Unit& u, int wr, int wc, int fr, int fq) const {
        const int row0 = u.pm * BM + wr * 64 + fr, col0 = u.pn * BM + wc * 32 + 8 * fq;
#pragma unroll
        for (int ai = 0; ai < 2; ++ai)
#pragma unroll
            for (int m = 0; m < 4; ++m) { bf16_t* rowp = O + (size_t)(row0 + ai * HALF + m * 16) * ldc + col0;
#pragma unroll
                for (int bj = 0; bj < 2; ++bj) { const f32x4 v0 = acc[ai][bj][m][0], v1 = acc[ai][bj][m][1];
                    u32x4 w; w.x = cvtpk(v0[0], v0[1]); w.y = cvtpk(v0[2], v0[3]); w.z = cvtpk(v1[0], v1[1]); w.w = cvtpk(v1[2], v1[3]);
                    *(u32x4*)(rowp + bj * HALF) = w; } }
    }
};
struct EpiT {
    static constexpr bool PERM = true, AFTER_DRAIN = false;
    bf16_t* O;
    DI void operator()(const f32x4 (&acc)[2][2][4][2], const Unit& u, int wr, int wc, int fr, int fq) const {
        const int br = u.pn >> 2;
        const int row0 = (u.pm - 128 * br) * BM + wr * 64 + fr, col0 = br * 1024 + (u.pn & 3) * BM + wc * 32 + 8 * fq;
#pragma unroll
        for (int ai = 0; ai < 2; ++ai)
#pragma unroll
            for (int m = 0; m < 4; ++m) { bf16_t* rowp = O + (size_t)(row0 + ai * HALF + m * 16) * 4096 + col0;
#pragma unroll
                for (int bj = 0; bj < 2; ++bj) { const f32x4 v0 = acc[ai][bj][m][0], v1 = acc[ai][bj][m][1];
                    u32x4 w; w.x = cvtpk(v0[0], v0[1]); w.y = cvtpk(v0[2], v0[3]); w.z = cvtpk(v1[0], v1[1]); w.w = cvtpk(v1[2], v1[3]);
                    *(u32x4*)(rowp + bj * HALF) = w; } }
    }
};
struct DiagOrder {
    int G, c;
    DI bool next(int i, Unit& u) const {
        const int L = i * G + c; if (L >= 2048) return false;
        const int br = L >> 9, rem = L & 511; u.pm = br * 128 + (rem >> 2); u.pn = br * 4 + (rem & 3); return true;
    }
    DI void a_ready(const Unit&) const {}
    DI void done(const Unit&) const {}
};
struct EpiMerge {
    static constexpr bool PERM = false, AFTER_DRAIN = false;
    const bf16_t* T; const float* bg; bf16_t* O;
    DI void operator()(const f32x4 (&acc)[2][2][4][2], const Unit& u, int wr, int wc, int fr, int fq) const {
        const int row0 = u.pm * BM + wr * 64 + fr, mc0 = u.pn * 64 + wc * 16 + 4 * fq;
        f32x4 bv[4];
#pragma unroll
        for (int i = 0; i < 4; ++i) bv[i] = *(const f32x4*)(bg + i * 1024 + mc0);
#pragma unroll
        for (int ai = 0; ai < 2; ++ai)
#pragma unroll
            for (int m = 0; m < 4; ++m) { const int row = row0 + ai * HALF + m * 16; const bf16_t* tp = T + (size_t)row * 4096 + mc0;
                f32x4 r = {0.f, 0.f, 0.f, 0.f};
#pragma unroll
                for (int i = 0; i < 4; ++i) { const u32x2 tv = *(const u32x2*)(tp + i * 1024); const f32x4 a = acc[ai][i >> 1][m][i & 1] + bv[i];
                    r[0] += sigmoidf_(a[0]) * bflo(tv.x); r[1] += sigmoidf_(a[1]) * bfhi(tv.x); r[2] += sigmoidf_(a[2]) * bflo(tv.y); r[3] += sigmoidf_(a[3]) * bfhi(tv.y); }
                u32x2 w; w.x = cvtpk(r[0], r[1]); w.y = cvtpk(r[2], r[3]);
                *(u32x2*)(O + (size_t)row * 1024 + mc0) = w; }
    }
};
struct EpiResid {
    static constexpr bool PERM = true, AFTER_DRAIN = false;
    const float* base; float* out;
    DI void operator()(const f32x4 (&acc)[2][2][4][2], const Unit& u, int wr, int wc, int fr, int fq) const {
        const int row0 = u.pm * BM + wr * 64 + fr, col0 = u.pn * BM + wc * 32 + 8 * fq;
#pragma unroll
        for (int ai = 0; ai < 2; ++ai)
#pragma unroll
            for (int m = 0; m < 4; ++m) { const size_t off = (size_t)(row0 + ai * HALF + m * 16) * 1024 + col0;
#pragma unroll
                for (int bj = 0; bj < 2; ++bj) {
                    const f32x4 b0 = *(const f32x4*)(base + off + bj * HALF), b1 = *(const f32x4*)(base + off + bj * HALF + 4);
                    *(f32x4*)(out + off + bj * HALF) = b0 + acc[ai][bj][m][0]; *(f32x4*)(out + off + bj * HALF + 4) = b1 + acc[ai][bj][m][1]; } }
    }
};
struct EpiSwiGLU {
    static constexpr bool PERM = true, AFTER_DRAIN = false;
    bf16_t* O;
    DI void operator()(const f32x4 (&acc)[2][2][4][2], const Unit& u, int wr, int wc, int fr, int fq) const {
        const int row0 = u.pm * BM + wr * 64 + fr, col0 = u.pn * 128 + wc * 32 + 8 * fq;
#pragma unroll
        for (int ai = 0; ai < 2; ++ai)
#pragma unroll
            for (int m = 0; m < 4; ++m) { bf16_t* rowp = O + (size_t)(row0 + ai * HALF + m * 16) * FF + col0;
                float r[8];
#pragma unroll
                for (int n = 0; n < 2; ++n)
#pragma unroll
                    for (int e = 0; e < 4; ++e) { const float g = acc[ai][0][m][n][e], up = acc[ai][1][m][n][e]; r[4 * n + e] = g * sigmoidf_(g) * up; }
                u32x4 w; w.x = cvtpk(r[0], r[1]); w.y = cvtpk(r[2], r[3]); w.z = cvtpk(r[4], r[5]); w.w = cvtpk(r[6], r[7]);
                *(u32x4*)rowp = w; }
    }
};
}
#define RLX_AGENT __ATOMIC_RELAXED, __HIP_MEMORY_SCOPE_AGENT
#define XB_TMO      128
#define XB_XCNT(j)  (256  + 64 * (j))
#define XB_XSUB(j)  (1280 + 64 * (j))
#define XB_XGEN(j)  (2304 + 64 * (j))
#define XB_TOP      3328
#define XB_TOPGEN   3392
#define XCD_BAR_WORDS 3456
#define XB_SPIN_CAP (1u << 18)

__device__ __forceinline__ unsigned xb_ld(unsigned* p)              { return __hip_atomic_load(p, __ATOMIC_RELAXED, __HIP_MEMORY_SCOPE_AGENT); }
__device__ __forceinline__ unsigned xb_add(unsigned* p, unsigned v) { return __hip_atomic_fetch_add(p, v, __ATOMIC_RELAXED, __HIP_MEMORY_SCOPE_AGENT); }
__device__ __forceinline__ unsigned xb_xcc_id() { return (unsigned)__builtin_amdgcn_s_getreg((3 << 11) | 20) & 0xFu; }
#define XB_SPIN(cond, bar) do { unsigned _sp = 0; while (cond) { __builtin_amdgcn_s_sleep(1); \
    if ((++_sp & 255u) == 0u) { if (xb_ld(&(bar)[XB_TMO])) break; if (_sp > XB_SPIN_CAP) { atomicAdd(&(bar)[XB_TMO], 1u); break; } } } } while (0)

struct XcdBarrier {
    unsigned* bar; unsigned x;
    volatile LAS unsigned* st;
};

__device__ __forceinline__ XcdBarrier xcd_barrier_post(unsigned* bar, volatile LAS unsigned* st) {
    XcdBarrier b; b.bar = bar; b.x = xb_xcc_id(); b.st = st;
    if (threadIdx.x == 0) (void)xb_add(&bar[XB_XCNT(b.x)], 1u);
    return b;
}
__device__ __forceinline__ void xcd_barrier_complete(unsigned* bar, unsigned x, unsigned& nloc, unsigned& nx) {
    const unsigned G = gridDim.x * gridDim.y * gridDim.z;
    unsigned sum, cnt, mine, sp = 0u;
    for (;;) {
        sum = 0u; cnt = 0u; mine = 0u;
#pragma unroll
        for (unsigned j = 0; j < 16; ++j) { const unsigned c = xb_ld(&bar[XB_XCNT(j)]); sum += c; cnt += (c > 0u) ? 1u : 0u; mine = (j == x) ? c : mine; }
        if (sum == G) break;
        __builtin_amdgcn_s_sleep(1);
        if ((++sp & 255u) == 0u) { if (xb_ld(&bar[XB_TMO])) break; if (sp > XB_SPIN_CAP) { atomicAdd(&bar[XB_TMO], 1u); break; } }
    }
    nloc = mine > 0u ? mine : 1u; nx = cnt > 0u ? cnt : 1u;
}

__device__ __forceinline__ void xcd_barrier(const XcdBarrier& b, const int wave_s) {
    asm volatile("s_waitcnt vmcnt(0)" ::: "memory");
    __syncthreads();
    if (wave_s == 0 && fresh_lane() == 0) {
        unsigned* bar = b.bar;
        __builtin_amdgcn_s_waitcnt(0);
        unsigned nloc = b.st[0], nx = b.st[1];
        if (nloc == 0u) { xcd_barrier_complete(bar, b.x, nloc, nx); b.st[0] = nloc; b.st[1] = nx; }
        const unsigned old = xb_add(&bar[XB_XSUB(b.x)], 1u);
        const unsigned gen = old / nloc;
        if (old + 1u == (gen + 1u) * nloc) {
            __builtin_amdgcn_fence(__ATOMIC_RELEASE, "agent");
            asm volatile("s_waitcnt vmcnt(0)" ::: "memory");
            const unsigned og = xb_add(&bar[XB_TOP], 1u);
            const unsigned tg = og / nx;
            if (og + 1u == (tg + 1u) * nx) xb_add(&bar[XB_TOPGEN], 1u);
            else XB_SPIN(xb_ld(&bar[XB_TOPGEN]) == tg, bar);
            __builtin_amdgcn_fence(__ATOMIC_ACQUIRE, "agent");
            xb_add(&bar[XB_XGEN(b.x)], 1u);
            asm volatile("s_waitcnt vmcnt(0)" ::: "memory");
        } else {
            XB_SPIN(xb_ld(&bar[XB_XGEN(b.x)]) == gen, bar);
            __builtin_amdgcn_fence(__ATOMIC_ACQUIRE, "agent");
            asm volatile("s_waitcnt vmcnt(0)" ::: "memory");
        }
    }
    __syncthreads();
}
struct Params { const float* in[21]; float* out; unsigned char* ws; };

DI float wave_sum(float v, int lane) {
#pragma unroll
    for (int o = 1; o < 32; o <<= 1) v += shx(v, o, lane);
    return v + shx32(v, lane);
}
#define LDS_WAIT() asm volatile("s_waitcnt lgkmcnt(0)" ::: "memory")

DI int rowmap(int mode, int arg, int n) {
    if (mode == 1) { const int pn = n >> 6, w = n & 63; return 256 * pn + 128 * (arg >> 1) + 32 * (w >> 4) + 16 * (arg & 1) + (w & 15); }
    if (mode == 2) { return 256 * (n >> 7) + 128 * arg + (n & 127); }
    return n;
}
struct TJob { const float* W; bf16_t* WT; int K, Nsrc, nblk, mode, arg; };
DI TJob get_job(const Params& P, int l, int j) {
    TJob t; unsigned char* wl = P.ws + WS_W + (size_t)l * WL_STRIDE; t.mode = 0; t.arg = 0;
    if (j == 0) { t.W = P.in[2] + (size_t)l * 1024 * INC; t.WT = (bf16_t*)(wl + WL_IN); t.K = 1024; t.Nsrc = INC; t.nblk = NIN / 32; }
    else if (j < 5) { const int i = j - 1; t.W = P.in[13] + (size_t)(l * 4 + i) * 1024 * 1024; t.WT = (bf16_t*)(wl + WL_G); t.K = 1024; t.Nsrc = 1024; t.nblk = 32; t.mode = 1; t.arg = i; }
    else if (j < 9) { const int i = j - 5; t.W = P.in[15] + (size_t)(l * 4 + i) * 256 * 1024; t.WT = (bf16_t*)(wl + WL_B) + (size_t)i * 1024 * 256; t.K = 256; t.Nsrc = 1024; t.nblk = 32; }
    else if (j == 9) { t.W = P.in[16] + (size_t)l * 1024 * 1024; t.WT = (bf16_t*)(wl + WL_O); t.K = 1024; t.Nsrc = 1024; t.nblk = 32; }
    else if (j < 12) { const int i = j - 10; t.W = P.in[18 + i] + (size_t)l * 1024 * FF; t.WT = (bf16_t*)(wl + WL_GU); t.K = 1024; t.Nsrc = FF; t.nblk = FF / 32; t.mode = 2; t.arg = i; }
    else if (j == 12) { t.W = P.in[20] + (size_t)l * FF * 1024; t.WT = (bf16_t*)(wl + WL_D); t.K = FF; t.Nsrc = 1024; t.nblk = 32; }
    else { const int kv = j - 13; t.W = P.in[12] + (size_t)(l * 2 + kv) * 2048 * 64; t.WT = (bf16_t*)(P.ws + WS_CWT) + (size_t)(l * 2 + kv) * 64 * 2048; t.K = 2048; t.Nsrc = 64; t.nblk = 2; }
    return t;
}
DI void transpose_item(const TJob& t, LAS float* scr, int item, int lane) {
    const int kb = item / t.nblk, nb = item % t.nblk, k0 = 64 * kb, n0 = 32 * nb;
    const int nn = n0 + (lane & 31);
#pragma unroll
    for (int i = 0; i < 32; ++i) { const int kk = 2 * i + (lane >> 5); scr[kk * 33 + (lane & 31)] = (nn < t.Nsrc) ? t.W[(size_t)(k0 + kk) * t.Nsrc + nn] : 0.f; }
    LDS_WAIT(); asm volatile("" ::: "memory");
    const int c = lane & 7;
#pragma unroll
    for (int j = 0; j < 4; ++j) { const int n = (lane >> 3) + 8 * j; const LAS float* s = scr + (8 * c) * 33 + n;
        u32x4 o; o.x = cvtpk(s[0 * 33], s[1 * 33]); o.y = cvtpk(s[2 * 33], s[3 * 33]); o.z = cvtpk(s[4 * 33], s[5 * 33]); o.w = cvtpk(s[6 * 33], s[7 * 33]);
        const int row = rowmap(t.mode, t.arg, n0 + n);
        *(u32x4*)(t.WT + (size_t)row * t.K + k0 + 8 * c) = o; }
    LDS_WAIT(); asm volatile("" ::: "memory");
}
DI void prologue_phase(const Params& P, LAS unsigned char* lds, int gw, int NGW, int wave, int lane) {
    LAS float* scr = (LAS float*)(lds + wave * 16384);
    for (int gi = gw; gi < 2 * 8960; gi += NGW) {
        const int l = gi >= 8960 ? 1 : 0; int r = gi - l * 8960, j, it;
        if (r < 1536) { j = 0; it = r; }
        else if ((r -= 1536) < 2048) { j = 1 + (r >> 9); it = r & 511; }
        else if ((r -= 2048) < 512) { j = 5 + (r >> 7); it = r & 127; }
        else if ((r -= 512) < 512) { j = 9; it = r; }
        else if ((r -= 512) < 2816) { j = 10 + (r >= 1408 ? 1 : 0); it = r >= 1408 ? r - 1408 : r; }
        else if ((r -= 2816) < 1408) { j = 12; it = r; }
        else { r -= 1408; j = 13 + (r >> 6); it = r & 63; }
        const TJob t = get_job(P, l, j);
        transpose_item(t, scr, it, lane);
    }
}

DI void rms_phase(const float* x, const float* g, bf16_t* out, int gw, int NGW, int lane) {
    f32x4 gv[4];
#pragma unroll
    for (int j = 0; j < 4; ++j) gv[j] = ((const f32x4*)g)[lane + 64 * j];
    for (int m = gw; m < TOK; m += 2 * NGW) {
        const int m2 = m + NGW; const bool has2 = m2 < TOK;
        const f32x4* xa = (const f32x4*)(x + (size_t)m * DM) + lane; const f32x4* xb = (const f32x4*)(x + (size_t)(has2 ? m2 : m) * DM) + lane;
        f32x4 va[4], vb[4]; float sa = 0.f, sb = 0.f;
#pragma unroll
        for (int j = 0; j < 4; ++j) { va[j] = xa[64 * j]; vb[j] = xb[64 * j]; }
#pragma unroll
        for (int j = 0; j < 4; ++j) { sa += (va[j].x * va[j].x + va[j].y * va[j].y) + (va[j].z * va[j].z + va[j].w * va[j].w);
                                      sb += (vb[j].x * vb[j].x + vb[j].y * vb[j].y) + (vb[j].z * vb[j].z + vb[j].w * vb[j].w); }
        const float ra = 1.0f / sqrtf(wave_sum(sa, lane) * (1.0f / DM) + RMS_EPS), rb = 1.0f / sqrtf(wave_sum(sb, lane) * (1.0f / DM) + RMS_EPS);
        unsigned long long* oa = (unsigned long long*)(out + (size_t)m * DM) + lane;
#pragma unroll
        for (int j = 0; j < 4; ++j) { const f32x4 y = va[j] * ra * gv[j]; oa[64 * j] = (unsigned long long)cvtpk(y.x, y.y) | ((unsigned long long)cvtpk(y.z, y.w) << 32); }
        if (has2) { unsigned long long* ob = (unsigned long long*)(out + (size_t)m2 * DM) + lane;
#pragma unroll
            for (int j = 0; j < 4; ++j) { const f32x4 y = vb[j] * rb * gv[j]; ob[64 * j] = (unsigned long long)cvtpk(y.x, y.y) | ((unsigned long long)cvtpk(y.z, y.w) << 32); } }
    }
}

DI void rope_cs(float pos, float inv, float& c, float& s) {
    const float ang = pos * inv; double rev = (double)ang * 0.15915494309189535; rev -= __builtin_rint(rev);
    const float r = (float)rev; s = __builtin_amdgcn_sinf(r); c = __builtin_amdgcn_cosf(r);
}
constexpr float LOG2_THETA = 18.931568569324174f;
DI void unpack8(const u32x4 w, float (&v)[8]) { v[0] = bflo(w.x); v[1] = bfhi(w.x); v[2] = bflo(w.y); v[3] = bfhi(w.y); v[4] = bflo(w.z); v[5] = bfhi(w.z); v[6] = bflo(w.w); v[7] = bfhi(w.w); }

constexpr float LOG2E_ = 1.4426950408889634f;
DI void prep_norm_item(const Params& P, int l, int it, int lane) {
    bf16_t* hb = (bf16_t*)(P.ws + WS_H);
    const int blk = it / 10, sp10 = it % 10, sp = sp10 < 4 ? 4 + sp10 : (sp10 < 8 ? 8 + sp10 : 12 + sp10), sub = lane & 7, tl = lane >> 3;
    int col; const float* g; bool diff = false, km = false; float qs = 1.0f;
    if (sp < 4) { col = C_DFQ + 64 * sp; g = P.in[3] + l * 32; diff = true; qs = 0.17677669529663687f * LOG2E_; }
    else if (sp < 8) { col = C_DFK + 64 * (sp - 4); g = P.in[4] + l * 32; diff = true; }
    else if (sp < 12) { col = C_MBQ + 64 * (sp - 8); g = P.in[7] + l * 64; qs = 0.125f * LOG2E_; }
    else if (sp < 16) { col = C_MBK + 64 * (sp - 12); g = P.in[8] + l * 64; km = true; }
    else if (sp < 20) { col = C_NSQ + 64 * (sp - 16); g = P.in[9] + l * 64; qs = 0.125f * LOG2E_; }
    else if (sp == 20) { col = C_KS; g = P.in[10] + (l * 3 + 1) * 64; }
    else { col = C_KW; g = P.in[10] + (l * 3 + 2) * 64; }
    float gv[8], inv[8], kacc[8];
#pragma unroll
    for (int e = 0; e < 8; ++e) { gv[e] = (diff ? g[8 * (sub & 3) + e] : g[8 * sub + e]); kacc[e] = 0.f;
        inv[e] = diff ? exp2f(-(float)(e & 3) * 0.25f * LOG2_THETA) : exp2f(-(float)e * 0.125f * LOG2_THETA); }
    u32x4* p0 = (u32x4*)(hb + (size_t)(blk * 64 + tl) * NIN + col + 8 * sub);
    u32x4 raw[8];
#pragma unroll
    for (int i = 0; i < 8; ++i) raw[i] = p0[(size_t)i * 8 * NIN / 8];
#pragma unroll
    for (int i = 0; i < 8; ++i) {
        const int tok = blk * 64 + 8 * i + tl; const float pos = (float)(tok & (SEQ - 1));
        float v[8]; unpack8(raw[i], v);
        float ss = 0.f;
#pragma unroll
        for (int e = 0; e < 8; ++e) ss += v[e] * v[e];
        ss += shx(ss, 1, lane); ss += shx(ss, 2, lane);
        if (!diff) ss += shx(ss, 4, lane);
        const float rstd = 1.0f / sqrtf(ss * (diff ? (1.0f / 32.0f) : (1.0f / 64.0f)) + RMS_EPS);
#pragma unroll
        for (int e = 0; e < 8; ++e) v[e] = v[e] * rstd * gv[e];
        if (diff) {
            if ((sub & 3) == 0) {
#pragma unroll
                for (int e = 0; e < 4; ++e) { float c, s; rope_cs(pos, inv[e], c, s); const float a = v[e], b = v[e + 4]; v[e] = a * c - b * s; v[e + 4] = b * c + a * s; }
            }
        } else {
            float pr[8];
#pragma unroll
            for (int e = 0; e < 8; ++e) pr[e] = shx(v[e], 1, lane);
            if (sub < 2) {
#pragma unroll
                for (int e = 0; e < 8; ++e) { float c, s; rope_cs(pos, inv[e], c, s); v[e] = (sub == 0) ? (v[e] * c - pr[e] * s) : (v[e] * c + pr[e] * s); }
            }
        }
#pragma unroll
        for (int e = 0; e < 8; ++e) kacc[e] += v[e];
        u32x4 w; w.x = cvtpk(v[0] * qs, v[1] * qs); w.y = cvtpk(v[2] * qs, v[3] * qs); w.z = cvtpk(v[4] * qs, v[5] * qs); w.w = cvtpk(v[6] * qs, v[7] * qs);
        p0[(size_t)i * 8 * NIN / 8] = w;
    }
    if (km) {
#pragma unroll
        for (int e = 0; e < 8; ++e) { float a = kacc[e]; a += shx(a, 8, lane); a += shx(a, 16, lane); a += shx32(a, lane); kacc[e] = a; }
        if (tl == 0) { float* kmp = (float*)(P.ws + WS_KMEAN) + ((((size_t)((blk >> 6) * 4 + (sp - 12)) * 16 + ((blk >> 2) & 15)) * 4 + (blk & 3)) * 64) + 8 * sub;
            *(f32x4*)kmp = (f32x4){kacc[0], kacc[1], kacc[2], kacc[3]}; *(f32x4*)(kmp + 4) = (f32x4){kacc[4], kacc[5], kacc[6], kacc[7]}; }
    }
}
#define MFMA32(a, b, c) __builtin_amdgcn_mfma_f32_32x32x16_bf16((a), (b), (c), 0, 0, 0)
DI void prep_compress_item(const Params& P, int l, int it, LAS unsigned char* lds, int wave, int lane) {
    const bf16_t* hb = (const bf16_t*)(P.ws + WS_H);
    const int kv = it & 1, nt = (it >> 1) & 7, b = it >> 4, r = lane & 31, h = lane >> 5;
    const bf16_t* cw = (const bf16_t*)(P.ws + WS_CWT) + (size_t)(l * 2 + kv) * 64 * 2048;
    const float* pe = P.in[11] + (size_t)(l * 2 + kv) * 32 * 64;
    const int col = kv ? C_VC : C_KC, n = 32 * nt + r;
    f32x16 acc[2];
#pragma unroll
    for (int i = 0; i < 16; ++i) { acc[0][i] = 0.f; acc[1][i] = 0.f; }
#pragma unroll
    for (int jj = 0; jj < 4; ++jj) {
        const int j = 4 * wave + jj;
        int tok = 16 * n + j; tok = tok > SEQ - 1 ? SEQ - 1 : tok;
        const bf16_t* xp = hb + (size_t)(b * SEQ + tok) * NIN + col + 8 * h;
#pragma unroll
        for (int ds = 0; ds < 4; ++ds) {
            float v[8]; unpack8(*(const u32x4*)(xp + 16 * ds), v);
            const f32x4 p0 = *(const f32x4*)(pe + j * 64 + 16 * ds + 8 * h), p1 = *(const f32x4*)(pe + j * 64 + 16 * ds + 8 * h + 4);
            u32x4 w; w.x = cvtpk(v[0] + p0[0], v[1] + p0[1]); w.y = cvtpk(v[2] + p0[2], v[3] + p0[3]); w.z = cvtpk(v[4] + p1[0], v[5] + p1[1]); w.w = cvtpk(v[6] + p1[2], v[7] + p1[3]);
            const bf16x8 bfrag = __builtin_bit_cast(bf16x8, w);
            const int k0 = j * 64 + 16 * ds + 8 * h;
            const bf16x8 a0 = *(const bf16x8*)(cw + (size_t)r * 2048 + k0), a1 = *(const bf16x8*)(cw + (size_t)(32 + r) * 2048 + k0);
            acc[0] = MFMA32(a0, bfrag, acc[0]); acc[1] = MFMA32(a1, bfrag, acc[1]);
        }
    }
    LAS float* part = (LAS float*)lds;
#pragma unroll
    for (int et = 0; et < 2; ++et)
#pragma unroll
        for (int i = 0; i < 16; ++i) part[(wave * 32 + et * 16 + i) * 64 + lane] = acc[et][i];
    __syncthreads();
    if (wave == 0) {
#pragma unroll
        for (int et = 0; et < 2; ++et)
#pragma unroll
            for (int i = 0; i < 16; ++i) { float a = acc[et][i];
#pragma unroll
                for (int w = 1; w < 8; ++w) a += part[(w * 32 + et * 16 + i) * 64 + lane];
                acc[et][i] = a; }
        if (kv == 0) {
            const float* g = P.in[10] + (size_t)(l * 3 + 0) * 64;
            float ss = 0.f;
#pragma unroll
            for (int i = 0; i < 16; ++i) ss += acc[0][i] * acc[0][i] + acc[1][i] * acc[1][i];
            ss += shx32(ss, lane);
            const float rstd = 1.0f / sqrtf(ss * (1.0f / 64.0f) + RMS_EPS);
#pragma unroll
            for (int et = 0; et < 2; ++et)
#pragma unroll
                for (int i = 0; i < 16; ++i) { const int e = 32 * et + (i & 3) + 8 * (i >> 2) + 4 * h; acc[et][i] = acc[et][i] * rstd * g[e]; }
            const float pos = (float)(16 * n + 31);
#pragma unroll
            for (int i = 0; i < 4; ++i) { const int e = 4 * h + i; float c, s; rope_cs(pos, exp2f(-(float)e * 0.125f * LOG2_THETA), c, s);
                const float a = acc[0][i], bq = acc[0][i + 4]; acc[0][i] = a * c - bq * s; acc[0][i + 4] = bq * c + a * s; }
        }
        bf16_t* dst = (bf16_t*)(P.ws + (kv ? WS_VC : WS_KC)) + (size_t)(b * 256 + n) * 64;
#pragma unroll
        for (int et = 0; et < 2; ++et)
#pragma unroll
            for (int gq = 0; gq < 4; ++gq) { u32x2 w; w.x = cvtpk(acc[et][4 * gq], acc[et][4 * gq + 1]); w.y = cvtpk(acc[et][4 * gq + 2], acc[et][4 * gq + 3]);
                *(u32x2*)(dst + 32 * et + 8 * gq + 4 * h) = w; }
    }
    __syncthreads();
}
DI void prep_phase(const Params& P, int l, LAS unsigned char* lds, int G, int bx, int gw, int NGW, int wave, int lane) {
    for (int it = bx; it < 128; it += G) prep_compress_item(P, l, it, lds, wave, lane);
    for (int it = gw; it < 512 * 10; it += NGW) prep_norm_item(P, l, it, lane);
}
typedef short v4i16_t __attribute__((ext_vector_type(4)));
constexpr int KP = 144;
constexpr int TILE_B = 64 * KP;
constexpr float LOG2E = 1.4426950408889634f;
enum { MODE_DIFF = 0, MODE_MOBA = 1, MODE_NSEL = 2, MODE_NWIN = 3 };

DI s16x4 vtr(LAS const char* p) { return __builtin_bit_cast(s16x4, __builtin_amdgcn_ds_read_tr16_b64_v4i16((LAS v4i16_t*)p)); }
DI float ex2(float x) { return __builtin_amdgcn_exp2f(x); }

template <int KS0, int KS1> DI f32x16 qk_rows(LAS const char* Kl, int row0, const bf16x8 (&qf)[4], int r, int h) {
    f32x16 s;
#pragma unroll
    for (int i = 0; i < 16; ++i) s[i] = 0.f;
    LAS const char* p = Kl + (row0 + r) * KP + 16 * h;
    bf16x8 kf[4];
#pragma unroll
    for (int ks = KS0; ks < KS1; ++ks) kf[ks] = *(LAS const bf16x8*)(p + 32 * ks);
    __builtin_amdgcn_s_setprio(1);
#pragma unroll
    for (int ks = KS0; ks < KS1; ++ks) s = MFMA32(kf[ks], qf[ks], s);
    __builtin_amdgcn_s_setprio(0);
    return s;
}
DI void pv_rows(f32x16 (&o)[2], LAS const char* Vl, int row0, const bf16x8 (&pf)[2], int lane) {
    const int h = lane >> 5, i = lane & 15, grp = (lane >> 4) & 1;
    LAS const char* base = Vl + (row0 + 4 * h + (i >> 2)) * KP + grp * 32 + (i & 3) * 8;
    bf16x8 vf[2][2];
#pragma unroll
    for (int dt = 0; dt < 2; ++dt)
#pragma unroll
        for (int s2 = 0; s2 < 2; ++s2) {
            const s16x4 lo = vtr(base + (16 * s2) * KP + dt * 64), hi = vtr(base + (16 * s2 + 8) * KP + dt * 64);
            vf[dt][s2] = (bf16x8){lo[0], lo[1], lo[2], lo[3], hi[0], hi[1], hi[2], hi[3]};
        }
    __builtin_amdgcn_s_setprio(1);
#pragma unroll
    for (int s2 = 0; s2 < 2; ++s2)
#pragma unroll
        for (int dt = 0; dt < 2; ++dt) o[dt] = MFMA32(vf[dt][s2], pf[s2], o[dt]);
    __builtin_amdgcn_s_setprio(0);
}
DI void pack_p(const float (&p)[16], bf16x8 (&pf)[2]) {
#pragma unroll
    for (int s2 = 0; s2 < 2; ++s2) { u32x4 w; w.x = cvtpk(p[8 * s2], p[8 * s2 + 1]); w.y = cvtpk(p[8 * s2 + 2], p[8 * s2 + 3]); w.z = cvtpk(p[8 * s2 + 4], p[8 * s2 + 5]); w.w = cvtpk(p[8 * s2 + 6], p[8 * s2 + 7]);
        pf[s2] = __builtin_bit_cast(bf16x8, w); }
}
template <int MM> DI void smax_step(const f32x16& s, unsigned vm, float& m, float& l, f32x16 (&o)[2], bf16x8 (&pf)[2], int lane) {
    float t[16], mx = -1e30f;
#pragma unroll
    for (int i = 0; i < 16; ++i) { t[i] = (MM == 0) ? s[i] : (MM == 1 ? (vm ? s[i] : -1e30f) : (((vm >> i) & 1u) ? s[i] : -1e30f)); mx = fmaxf(mx, t[i]); }
    mx = fmaxf(mx, shx32(mx, lane));
    const float mn = (mx > m + 8.0f) ? mx : m;
    const float mref = fmaxf(mn, -1e29f);
    float p[16], rs = 0.f;
#pragma unroll
    for (int i = 0; i < 16; ++i) { p[i] = ex2(t[i] - mref); rs += p[i]; }
    rs += shx32(rs, lane);
    if (__builtin_amdgcn_ballot_w64(mn != m) != 0ull) {
        const float alpha = ex2(m - mn);
        l *= alpha;
#pragma unroll
        for (int i = 0; i < 16; ++i) { o[0][i] *= alpha; o[1][i] *= alpha; }
        m = mn;
    }
    l += rs;
    pack_p(p, pf);
}
template <int MM> DI void smax_step64(const f32x16& sa, const f32x16& sb, unsigned vm, float& m, float& l, f32x16 (&o)[2], bf16x8 (&pf)[4], int lane) {
    float mx = -1e30f;
#pragma unroll
    for (int i = 0; i < 16; ++i) mx = fmaxf(mx, fmaxf(sa[i], sb[i]));
    if (MM == 1) mx = vm ? mx : -1e30f;
    mx = fmaxf(mx, shx32(mx, lane));
    const float mn = (mx > m + 8.0f) ? mx : m;
    float mref = fmaxf(mn, -1e29f);
    if (MM == 1) mref = vm ? mref : 3e38f;
    float rs = 0.f;
    {   float pa[16]; bf16x8 t2[2];
#pragma unroll
        for (int i = 0; i < 16; ++i) { pa[i] = ex2(sa[i] - mref); rs += pa[i]; }
        pack_p(pa, t2); pf[0] = t2[0]; pf[1] = t2[1]; }
    {   float pb[16]; bf16x8 t2[2];
#pragma unroll
        for (int i = 0; i < 16; ++i) { pb[i] = ex2(sb[i] - mref); rs += pb[i]; }
        pack_p(pb, t2); pf[2] = t2[0]; pf[3] = t2[1]; }
    rs += shx32(rs, lane);
    if (__builtin_amdgcn_ballot_w64(mn != m) != 0ull) {
        const float alpha = ex2(m - mn);
        l *= alpha;
#pragma unroll
        for (int i = 0; i < 16; ++i) { o[0][i] *= alpha; o[1][i] *= alpha; }
        m = mn;
    }
    l += rs;
}
DI void pv_rows64(f32x16 (&o)[2], LAS const char* Vl, const bf16x8 (&pf)[4], int lane) {
    const int h = lane >> 5, i = lane & 15, grp = (lane >> 4) & 1;
    LAS const char* base = Vl + (4 * h + (i >> 2)) * KP + grp * 32 + (i & 3) * 8;
#pragma unroll
    for (int s4 = 0; s4 < 4; ++s4)
#pragma unroll
        for (int dt = 0; dt < 2; ++dt) {
            const s16x4 lo = vtr(base + (16 * s4) * KP + dt * 64), hi = vtr(base + (16 * s4 + 8) * KP + dt * 64);
            const bf16x8 vf = {lo[0], lo[1], lo[2], lo[3], hi[0], hi[1], hi[2], hi[3]};
            o[dt] = MFMA32(vf, pf[s4], o[dt]);
        }
}
template <int MM> DI void smax_step_nb(const f32x16& s, unsigned vm, float& m, float& l, f32x16 (&o)[2], bf16x8 (&pf)[2], int lane) {
    float mx = -1e30f;
#pragma unroll
    for (int i = 0; i < 16; ++i) mx = fmaxf(mx, s[i]);
    if (MM == 1) mx = vm ? mx : -1e30f;
    mx = fmaxf(mx, shx32(mx, lane));
    const float mn = (mx > m + 8.0f) ? mx : m;
    float mref = fmaxf(mn, -1e29f);
    if (MM == 1) mref = vm ? mref : 3e38f;
    const float alpha = ex2(m - mn);
    float p[16], rs = 0.f;
#pragma unroll
    for (int i = 0; i < 16; ++i) { p[i] = ex2(s[i] - mref); rs += p[i]; }
    rs += shx32(rs, lane);
    l = l * alpha + rs;
    if (__builtin_amdgcn_ballot_w64(mn != m) != 0ull) {
#pragma unroll
        for (int i = 0; i < 16; ++i) { o[0][i] *= alpha; o[1][i] *= alpha; }
    }
    m = mn;
    pack_p(p, pf);
}
template <int MM> DI void tile64_pipe(LAS const char* Kl, LAS const char* Vl, const bf16x8 (&qf)[4], unsigned vm, float& m, float& l, f32x16 (&o)[2], int r, int h, int lane) {
    const f32x16 sa = qk_rows<0, 4>(Kl, 0, qf, r, h), sb = qk_rows<0, 4>(Kl, 32, qf, r, h);
    bf16x8 pfa[2], pfb[2];
    smax_step_nb<MM>(sa, vm, m, l, o, pfa, lane);
    pv_rows(o, Vl, 0, pfa, lane);
    smax_step_nb<MM>(sb, vm, m, l, o, pfb, lane);
    pv_rows(o, Vl, 32, pfb, lane);
}
template <int MM> DI void tile128_pipe(LAS const char* K0, LAS const char* V0, LAS const char* K1, LAS const char* V1, const bf16x8 (&qf)[4], unsigned vm0, unsigned vm1,
                                       float& m, float& l, f32x16 (&o)[2], int r, int h, int lane) {
    f32x16 sa = qk_rows<0, 4>(K0, 0, qf, r, h), sb = qk_rows<0, 4>(K0, 32, qf, r, h);
    bf16x8 pfa[2], pfb[2];
    smax_step_nb<MM>(sa, vm0, m, l, o, pfa, lane);
    sa = qk_rows<0, 4>(K1, 0, qf, r, h);
    pv_rows(o, V0, 0, pfa, lane);
    smax_step_nb<MM>(sb, vm0, m, l, o, pfb, lane);
    sb = qk_rows<0, 4>(K1, 32, qf, r, h);
    pv_rows(o, V0, 32, pfb, lane);
    smax_step_nb<MM>(sa, vm1, m, l, o, pfa, lane);
    pv_rows(o, V1, 0, pfa, lane);
    smax_step_nb<MM>(sb, vm1, m, l, o, pfb, lane);
    pv_rows(o, V1, 32, pfb, lane);
}
struct Stage { u32x4 k, v; };
DI void stage_load(Stage& st, const bf16_t* Kg, const bf16_t* Vg, int pitch, int key0, int tid) {
    const int key = tid >> 3, c = tid & 7;
    st.k = *(const u32x4*)(Kg + (size_t)(key0 + key) * pitch + 8 * c); st.v = *(const u32x4*)(Vg + (size_t)(key0 + key) * pitch + 8 * c);
}
DI void stage_store(const Stage& st, LAS char* Kl, LAS char* Vl, int tid) {
    const int key = tid >> 3, c = tid & 7;
    *(LAS u32x4*)(Kl + key * KP + 16 * c) = st.k; *(LAS u32x4*)(Vl + key * KP + 16 * c) = st.v;
}
DI void zero_o(f32x16 (&o)[2]) {
#pragma unroll
    for (int i = 0; i < 16; ++i) { o[0][i] = 0.f; o[1][i] = 0.f; }
}
DI void load_q(bf16x8 (&qf)[4], const bf16_t* qrow, int h) {
#pragma unroll
    for (int ks = 0; ks < 4; ++ks) qf[ks] = *(const bf16x8*)(qrow + 16 * ks + 8 * h);
}
DI void store_o(bf16_t* dst, const f32x16 (&o)[2], int h) {
#pragma unroll
    for (int dt = 0; dt < 2; ++dt)
#pragma unroll
        for (int g = 0; g < 4; ++g) { u32x2 w; w.x = cvtpk(o[dt][4 * g], o[dt][4 * g + 1]); w.y = cvtpk(o[dt][4 * g + 2], o[dt][4 * g + 3]);
            *(u32x2*)(dst + 32 * dt + 8 * g + 4 * h) = w; }
}

template <bool DIFFQ> DI void norm_rope_q(bf16x8 (&qf)[4], const float* g, float qs, int qpos, int h, int lane) {
    float qv[4][8];
#pragma unroll
    for (int ks = 0; ks < 4; ++ks) unpack8(__builtin_bit_cast(u32x4, qf[ks]), qv[ks]);
    float ssa = 0.f, ssb = 0.f;
#pragma unroll
    for (int j = 0; j < 8; ++j) { ssa += qv[0][j] * qv[0][j] + qv[1][j] * qv[1][j]; ssb += qv[2][j] * qv[2][j] + qv[3][j] * qv[3][j]; }
    ssa += shx32(ssa, lane); ssb += shx32(ssb, lane);
    float ra, rb;
    if (DIFFQ) { ra = 1.0f / sqrtf(ssa * (1.0f / 32.0f) + RMS_EPS); rb = 1.0f / sqrtf(ssb * (1.0f / 32.0f) + RMS_EPS); }
    else { ra = rb = 1.0f / sqrtf((ssa + ssb) * (1.0f / 64.0f) + RMS_EPS); }
#pragma unroll
    for (int ks = 0; ks < 4; ++ks)
#pragma unroll
        for (int j = 0; j < 8; ++j) { const int d = 16 * ks + 8 * h + j; qv[ks][j] = qv[ks][j] * (ks < 2 ? ra : rb) * g[DIFFQ ? (d & 31) : d]; }
    const float pos = (float)qpos;
    if (DIFFQ) {
        if (h == 0) {
#pragma unroll
            for (int mp = 0; mp < 2; ++mp)
#pragma unroll
                for (int e = 0; e < 4; ++e) { float c, sn; rope_cs(pos, exp2f(-(float)e * 0.25f * LOG2_THETA), c, sn);
                    const float a = qv[2 * mp][e], bq = qv[2 * mp][e + 4]; qv[2 * mp][e] = a * c - bq * sn; qv[2 * mp][e + 4] = bq * c + a * sn; }
        }
    } else {
        float pr[8];
#pragma unroll
        for (int j = 0; j < 8; ++j) pr[j] = shx32(qv[0][j], lane);
#pragma unroll
        for (int e = 0; e < 8; ++e) { float c, sn; rope_cs(pos, exp2f(-(float)e * 0.125f * LOG2_THETA), c, sn);
            qv[0][e] = (h == 0) ? (qv[0][e] * c - pr[e] * sn) : (qv[0][e] * c + pr[e] * sn); }
    }
#pragma unroll
    for (int ks = 0; ks < 4; ++ks) { u32x4 w; w.x = cvtpk(qv[ks][0] * qs, qv[ks][1] * qs); w.y = cvtpk(qv[ks][2] * qs, qv[ks][3] * qs); w.z = cvtpk(qv[ks][4] * qs, qv[ks][5] * qs); w.w = cvtpk(qv[ks][6] * qs, qv[ks][7] * qs);
        qf[ks] = __builtin_bit_cast(bf16x8, w); }
}
struct Stage2 { u32x4 k0, v0, k1, v1; };
DI void flash_prefetch(Stage2& st, const bf16_t* Kg, const bf16_t* Vg, int pitch, int kt_lo, int kt_hi, int tid) {
    const int skey = tid >> 3, sc = tid & 7, t1 = (kt_lo + 1 > kt_hi) ? kt_hi : kt_lo + 1;
    const size_t a0 = (size_t)(64 * kt_lo + skey) * pitch + 8 * sc, a1 = (size_t)(64 * t1 + skey) * pitch + 8 * sc;
    st.k0 = *(const u32x4*)(Kg + a0); st.v0 = *(const u32x4*)(Vg + a0); st.k1 = *(const u32x4*)(Kg + a1); st.v1 = *(const u32x4*)(Vg + a1);
}
template <int MODE, bool PRE = false>
DI void flash_tiles(LAS char* lds, const bf16_t* Kg, const bf16_t* Vg, int pitch, int kt_lo, int kt_hi,
                    const bf16x8 (&qf)[4], int qpos, int q0w, unsigned long long sel, float c,
                    float& m1, float& l1, f32x16 (&o1)[2], float& m2, float& l2, f32x16 (&o2)[2], int tid, int lane, Stage2& st) {
    const int n = kt_hi - kt_lo + 1;
    if (n <= 0) return;
    const int r = lane & 31, h = lane >> 5, nst = (n + 1) >> 1;
    const int skey = tid >> 3, sc = tid & 7;
#define ST2_LOAD(T0) do { const int t0_ = (T0), t1_ = (t0_ + 1 > kt_hi) ? kt_hi : t0_ + 1; \
        const size_t a0_ = (size_t)(64 * t0_ + skey) * pitch + 8 * sc, a1_ = (size_t)(64 * t1_ + skey) * pitch + 8 * sc; \
        st.k0 = *(const u32x4*)(Kg + a0_); st.v0 = *(const u32x4*)(Vg + a0_); st.k1 = *(const u32x4*)(Kg + a1_); st.v1 = *(const u32x4*)(Vg + a1_); } while (0)
#define ST2_STORE(BUF) do { LAS char* b_ = lds + (BUF) * 4 * TILE_B + skey * KP + 16 * sc; \
        *(LAS u32x4*)(b_) = st.k0; *(LAS u32x4*)(b_ + TILE_B) = st.v0; *(LAS u32x4*)(b_ + 2 * TILE_B) = st.k1; *(LAS u32x4*)(b_ + 3 * TILE_B) = st.v1; } while (0)
    if (!PRE) ST2_LOAD(kt_lo);
    ST2_STORE(0);
    __syncthreads();
    for (int sti = 0; sti < nst; ++sti) {
        if (sti + 1 < nst) ST2_LOAD(kt_lo + 2 * (sti + 1));
        if (MODE != MODE_DIFF) {
            const int kt0 = kt_lo + 2 * sti;
            bool both = (kt0 + 1 <= kt_hi) && (64 * kt0 + 127 <= q0w);
            if (MODE == MODE_NWIN) both = both && (64 * kt0 > q0w + 31 - 512);
            if (both) {
                bool ls0 = true, ls1 = true;
                if (MODE == MODE_MOBA) { ls0 = ((sel >> (kt0 >> 2)) & 1ull) != 0ull; ls1 = ((sel >> ((kt0 + 1) >> 2)) & 1ull) != 0ull; }
                if (MODE == MODE_NSEL) { ls0 = ((sel >> kt0) & 1ull) != 0ull; ls1 = ((sel >> (kt0 + 1)) & 1ull) != 0ull; }
                const unsigned long long b0 = __builtin_amdgcn_ballot_w64(ls0), b1 = __builtin_amdgcn_ballot_w64(ls1);
                if (b0 != 0ull && b1 != 0ull) {
                    LAS char* K0 = lds + (sti & 1) * 4 * TILE_B;
                    if ((b0 & b1) == ~0ull) tile128_pipe<0>(K0, K0 + TILE_B, K0 + 2 * TILE_B, K0 + 3 * TILE_B, qf, 1u, 1u, m1, l1, o1, r, h, lane);
                    else tile128_pipe<1>(K0, K0 + TILE_B, K0 + 2 * TILE_B, K0 + 3 * TILE_B, qf, ls0 ? 1u : 0u, ls1 ? 1u : 0u, m1, l1, o1, r, h, lane);
                    goto step_done;
                }
            }
        }
#pragma unroll 1
        for (int half = 0; half < 2; ++half) {
        const int kt = kt_lo + 2 * sti + half;
        if (kt > kt_hi) break;
        LAS char* Kl = lds + (sti & 1) * 4 * TILE_B + half * 2 * TILE_B; LAS char* Vl = Kl + TILE_B;
        bool full2 = (64 * kt + 63 <= q0w);
        if (MODE == MODE_NWIN) full2 = full2 && (64 * kt > q0w + 31 - 512);
        if (full2 && (MODE != MODE_DIFF || DIFF_MERGED)) {
            bool lsel = true;
            if (MODE == MODE_MOBA) lsel = ((sel >> (kt >> 2)) & 1ull) != 0ull;
            if (MODE == MODE_NSEL) lsel = ((sel >> kt) & 1ull) != 0ull;
            const unsigned long long selb = __builtin_amdgcn_ballot_w64(lsel);
            if (selb != 0ull) {
                const unsigned vm = lsel ? 1u : 0u; bf16x8 pf[4];
                if (MODE == MODE_DIFF) {
                    { const f32x16 sa = qk_rows<0, 2>(Kl, 0, qf, r, h), sb = qk_rows<0, 2>(Kl, 32, qf, r, h);
                      smax_step64<0>(sa, sb, vm, m1, l1, o1, pf, lane); __builtin_amdgcn_sched_barrier(0); pv_rows64(o1, Vl, pf, lane); }
                    __builtin_amdgcn_sched_barrier(0);
                    { const f32x16 sa = qk_rows<2, 4>(Kl, 0, qf, r, h), sb = qk_rows<2, 4>(Kl, 32, qf, r, h);
                      smax_step64<0>(sa, sb, vm, m2, l2, o2, pf, lane); __builtin_amdgcn_sched_barrier(0); pv_rows64(o2, Vl, pf, lane); }
                } else {
#if PIPE64
                    if (selb == ~0ull) tile64_pipe<0>(Kl, Vl, qf, vm, m1, l1, o1, r, h, lane); else tile64_pipe<1>(Kl, Vl, qf, vm, m1, l1, o1, r, h, lane);
#else
                    const f32x16 sa = qk_rows<0, 4>(Kl, 0, qf, r, h), sb = qk_rows<0, 4>(Kl, 32, qf, r, h);
                    if (selb == ~0ull) smax_step64<0>(sa, sb, vm, m1, l1, o1, pf, lane); else smax_step64<1>(sa, sb, vm, m1, l1, o1, pf, lane);
                    pv_rows64(o1, Vl, pf, lane);
#endif
                }
            }
        } else
#pragma unroll
        for (int sub = 0; sub < 2; ++sub) {
            const int kbase = 64 * kt + 32 * sub;
            if (kbase > q0w + 31) continue;
            if (MODE == MODE_NWIN && kbase + 31 <= q0w - 512) continue;
            bool full = (kbase + 31 <= q0w);
            if (MODE == MODE_NWIN) full = full && (kbase > q0w + 31 - 512);
            bool lsel = true;
            if (MODE == MODE_MOBA) lsel = ((sel >> (kbase >> 8)) & 1ull) != 0ull;
            if (MODE == MODE_NSEL) lsel = ((sel >> kt) & 1ull) != 0ull;
            const unsigned long long selb = __builtin_amdgcn_ballot_w64(lsel);
            if (selb == 0ull) continue;
            int mm; unsigned vm;
            if (full) { mm = (selb == ~0ull) ? 0 : 1; vm = lsel ? 1u : 0u; }
            else { mm = 2; vm = 0;
#pragma unroll
                for (int i = 0; i < 16; ++i) { const int kidx = kbase + (i & 3) + 8 * (i >> 2) + 4 * h; bool ok = kidx <= qpos; if (MODE == MODE_NWIN) ok = ok && (kidx > qpos - 512); vm |= ok ? (1u << i) : 0u; }
                if (!lsel) vm = 0;
                if (__builtin_amdgcn_ballot_w64(vm != 0) == 0ull) continue; }
            bf16x8 pf[2];
            if (MODE == MODE_DIFF) {
                const f32x16 s1 = qk_rows<0, 2>(Kl, 32 * sub, qf, r, h), s2 = qk_rows<2, 4>(Kl, 32 * sub, qf, r, h);
                bf16x8 pf2[2];
                if (mm == 0) { smax_step<0>(s1, vm, m1, l1, o1, pf, lane); smax_step<0>(s2, vm, m2, l2, o2, pf2, lane); }
                else { smax_step<2>(s1, vm, m1, l1, o1, pf, lane); smax_step<2>(s2, vm, m2, l2, o2, pf2, lane); }
                pv_rows(o1, Vl, 32 * sub, pf, lane);
                pv_rows(o2, Vl, 32 * sub, pf2, lane);
            } else {
                const f32x16 s = qk_rows<0, 4>(Kl, 32 * sub, qf, r, h);
                if (mm == 0) smax_step<0>(s, vm, m1, l1, o1, pf, lane); else if (mm == 1) smax_step<1>(s, vm, m1, l1, o1, pf, lane); else smax_step<2>(s, vm, m1, l1, o1, pf, lane);
                pv_rows(o1, Vl, 32 * sub, pf, lane);
            }
        }
        }
        step_done:
        if (sti + 1 < nst) ST2_STORE((sti + 1) & 1);
        __syncthreads();
    }
#undef ST2_LOAD
#undef ST2_STORE
}

DI void sb_unit(const Params& P, LAS char* lds, int b, int hd, int qb, int wave, int lane) {
    const bf16_t* hb = (const bf16_t*)(P.ws + WS_H);
    const int r = lane & 31, h = lane >> 5, q0w = 256 * qb + 32 * wave, qpos = q0w + r;
    bf16x8 qf[4]; load_q(qf, hb + (size_t)(b * SEQ + qpos) * NIN + C_SBQ + 64 * hd, h);
    const bf16_t* Kg = hb + (size_t)b * SEQ * NIN + C_SBK + 64 * hd; const bf16_t* Vg = hb + (size_t)b * SEQ * NIN + C_SBV + 64 * hd;
    LAS char* Kl = lds + wave * 9216; LAS char* Vl = Kl + 4608;
    f32x16 o[2]; zero_o(o);
    float carry = 0.f;
    u32x4 kr[2][4], vr[2][4];
#define SB_LOAD(KB, PAR) do { _Pragma("unroll") for (int jj = 0; jj < 4; ++jj) { const int ch = lane + 64 * jj, key = ch >> 3, cc = ch & 7; \
        kr[PAR][jj] = *(const u32x4*)(Kg + (size_t)((KB) + key) * NIN + 8 * cc); vr[PAR][jj] = *(const u32x4*)(Vg + (size_t)((KB) + key) * NIN + 8 * cc); } } while (0)
    SB_LOAD(q0w, 0);
    if (q0w >= 32) SB_LOAD(q0w - 32, 1);
    bool done = false;
    for (int st0 = q0w >> 5; st0 >= 0 && !done; st0 -= 2) {
#pragma unroll
    for (int par = 0; par < 2; ++par) {
        const int st = st0 - par;
        if (st < 0 || done) continue;
        const int kbase = 32 * st;
        asm volatile("" ::: "memory");
#pragma unroll
        for (int jj = 0; jj < 4; ++jj) { const int ch = lane + 64 * jj, key = ch >> 3, cc = ch & 7;
            *(LAS u32x4*)(Kl + key * KP + 16 * cc) = kr[par][jj]; *(LAS u32x4*)(Vl + key * KP + 16 * cc) = vr[par][jj]; }
        if (st >= 2) SB_LOAD(kbase - 64, par);
        LDS_WAIT(); asm volatile("" ::: "memory");
        const f32x16 s = qk_rows<0, 4>(Kl, 0, qf, r, h);
        float l1m[16], ls[16];
        unsigned vm = 0;
#pragma unroll
        for (int i = 0; i < 16; ++i) { const int kidx = kbase + (i & 3) + 8 * (i >> 2) + 4 * h; const bool ok = kidx < qpos; vm |= ok ? (1u << i) : 0u;
            const float z = s[i] * 0.125f; const float sp = fmaxf(z, 0.f) + __logf(1.0f + __expf(-fabsf(z)));
            l1m[i] = ok ? -sp : 0.f; ls[i] = z - sp; }
        float G[4], Gp[4], tot[4];
#pragma unroll
        for (int g = 0; g < 4; ++g) { G[g] = (l1m[4 * g] + l1m[4 * g + 1]) + (l1m[4 * g + 2] + l1m[4 * g + 3]); Gp[g] = shx32(G[g], lane); tot[g] = G[g] + Gp[g]; }
        float aft[4];
        aft[3] = (h == 0) ? Gp[3] : 0.f;
        aft[2] = tot[3] + ((h == 0) ? Gp[2] : 0.f);
        aft[1] = tot[3] + tot[2] + ((h == 0) ? Gp[1] : 0.f);
        aft[0] = tot[3] + tot[2] + tot[1] + ((h == 0) ? Gp[0] : 0.f);
        float p[16];
#pragma unroll
        for (int g = 0; g < 4; ++g) {
            const float base = carry + aft[g];
            const float w3 = 0.f, w2 = l1m[4 * g + 3], w1 = w2 + l1m[4 * g + 2], w0 = w1 + l1m[4 * g + 1];
            p[4 * g + 0] = ((vm >> (4 * g + 0)) & 1u) ? __expf(ls[4 * g + 0] + base + w0) : 0.f;
            p[4 * g + 1] = ((vm >> (4 * g + 1)) & 1u) ? __expf(ls[4 * g + 1] + base + w1) : 0.f;
            p[4 * g + 2] = ((vm >> (4 * g + 2)) & 1u) ? __expf(ls[4 * g + 2] + base + w2) : 0.f;
            p[4 * g + 3] = ((vm >> (4 * g + 3)) & 1u) ? __expf(ls[4 * g + 3] + base + w3) : 0.f;
        }
        carry += (tot[0] + tot[1]) + (tot[2] + tot[3]);
        bf16x8 pf[2]; pack_p(p, pf);
        pv_rows(o, Vl, 0, pf, lane);
        asm volatile("" ::: "memory");
        if (__builtin_amdgcn_ballot_w64(carry >= -120.0f) == 0ull) done = true;
    }
    }
#undef SB_LOAD
    store_o((bf16_t*)(P.ws + WS_O) + ((size_t)0 * TOK + (size_t)b * SEQ + qpos) * 256 + 64 * hd, o, h);
}

DI void diff_unit(const Params& P, int l, LAS char* lds, int b, int hd, int qb, int tid, int wave, int lane) {
    const bf16_t* hb = (const bf16_t*)(P.ws + WS_H);
    const int r = lane & 31, h = lane >> 5, q0w = 256 * qb + 32 * wave, qpos = q0w + r;
    bf16x8 qf[4]; load_q(qf, hb + (size_t)(b * SEQ + qpos) * NIN + C_DFQ + 64 * hd, h);
    Stage2 st0; flash_prefetch(st0, hb + (size_t)b * SEQ * NIN + C_DFK + 64 * hd, hb + (size_t)b * SEQ * NIN + C_DFV + 64 * hd, NIN, 0, 4 * qb + 3, tid);
    norm_rope_q<true>(qf, P.in[3] + (size_t)l * 32, 0.17677669529663687f * LOG2E, qpos & (SEQ - 1), h, lane);
    const bf16_t* Kg = hb + (size_t)b * SEQ * NIN + C_DFK + 64 * hd; const bf16_t* Vg = hb + (size_t)b * SEQ * NIN + C_DFV + 64 * hd;
    f32x16 o1[2], o2[2]; zero_o(o1); zero_o(o2);
    float m1 = -1e30f, l1 = 0.f, m2 = -1e30f, l2 = 0.f;
    flash_tiles<MODE_DIFF, true>(lds, Kg, Vg, NIN, 0, 4 * qb + 3, qf, qpos, q0w, 0ull, 1.0f, m1, l1, o1, m2, l2, o2, tid, lane, st0);
    const float* lp = P.in[5] + (size_t)l * 4 * 32;
    float s01 = (lane < 32) ? lp[lane] * lp[32 + lane] : 0.f, s23 = (lane < 32) ? lp[64 + lane] * lp[96 + lane] : 0.f;
    s01 = wave_sum(s01, lane); s23 = wave_sum(s23, lane);
    float lf = (float)l; asm volatile("" : "+v"(lf));
    const float lam_init = 0.8f - 0.6f * expf(-0.3f * lf);
    const float lam = expf(s01) - expf(s23) + lam_init;
    const float i1 = 1.0f / l1, i2 = lam / l2;
    float ss = 0.f;
#pragma unroll
    for (int dt = 0; dt < 2; ++dt)
#pragma unroll
        for (int i = 0; i < 16; ++i) { const float v = o1[dt][i] * i1 - o2[dt][i] * i2; o1[dt][i] = v; ss += v * v; }
    ss += shx32(ss, lane);
    const float rstd = (1.0f - lam_init) / sqrtf(ss * (1.0f / 64.0f) + RMS_EPS);
    const float* sg = P.in[6] + (size_t)l * 64;
#pragma unroll
    for (int dt = 0; dt < 2; ++dt)
#pragma unroll
        for (int i = 0; i < 16; ++i) o1[dt][i] = o1[dt][i] * rstd * sg[32 * dt + (i & 3) + 8 * (i >> 2) + 4 * h];
    store_o((bf16_t*)(P.ws + WS_O) + ((size_t)1 * TOK + (size_t)b * SEQ + qpos) * 256 + 64 * hd, o1, h);
}

DI void moba_unit(const Params& P, int l, LAS char* lds, int b, int hd, int qb, int tid, int wave, int lane) {
    const bf16_t* hb = (const bf16_t*)(P.ws + WS_H);
    const int r = lane & 31, h = lane >> 5, q0w = 256 * qb + 32 * wave, qpos = q0w + r;
    LAS float* kmL = (LAS float*)(lds + 8 * TILE_B);
    const float* kmg = (const float*)(P.ws + WS_KMEAN) + (size_t)(b * 4 + hd) * 16 * 4 * 64;
#pragma unroll
    for (int u = 0; u < 2; ++u) { const int e = tid + 512 * u, nb = e >> 6, d = e & 63; const float* q4 = kmg + (size_t)nb * 256 + d;
        kmL[e] = (((q4[0] + q4[64]) + q4[128]) + q4[192]) * (1.0f / 256.0f); }
    __syncthreads();
    bf16x8 qf[4]; load_q(qf, hb + (size_t)(b * SEQ + qpos) * NIN + C_MBQ + 64 * hd, h);
    Stage2 st0; flash_prefetch(st0, hb + (size_t)b * SEQ * NIN + C_MBK + 64 * hd, hb + (size_t)b * SEQ * NIN + C_MBV + 64 * hd, NIN, 0, 4 * qb + 3, tid);
    norm_rope_q<false>(qf, P.in[7] + (size_t)l * 64, 0.125f * LOG2E, qpos, h, lane);
    float qv[4][8];
#pragma unroll
    for (int ks = 0; ks < 4; ++ks) unpack8(__builtin_bit_cast(u32x4, qf[ks]), qv[ks]);
    float v0 = -3e38f, v1 = -3e38f, v2 = -3e38f; int i0 = -1, i1 = -1, i2 = -1;
#pragma unroll 1
    for (int n = 0; n < qb; ++n) {
        float g = 0.f;
#pragma unroll
        for (int ks = 0; ks < 4; ++ks) { const f32x4 a = *(LAS const f32x4*)(kmL + n * 64 + 16 * ks + 8 * h), bq = *(LAS const f32x4*)(kmL + n * 64 + 16 * ks + 8 * h + 4);
            g += (qv[ks][0] * a[0] + qv[ks][1] * a[1]) + (qv[ks][2] * a[2] + qv[ks][3] * a[3]) + (qv[ks][4] * bq[0] + qv[ks][5] * bq[1]) + (qv[ks][6] * bq[2] + qv[ks][7] * bq[3]); }
        g += shx32(g, lane);
        if (g > v0) { v2 = v1; i2 = i1; v1 = v0; i1 = i0; v0 = g; i0 = n; }
        else if (g > v1) { v2 = v1; i2 = i1; v1 = g; i1 = n; }
        else if (g > v2) { v2 = g; i2 = n; }
    }
    unsigned bm = 0;
    if (i0 >= 0) bm |= 1u << i0;
    if (i1 >= 0) bm |= 1u << i1;
    if (i2 >= 0) bm |= 1u << i2;
    bm |= 1u << qb;
    f32x16 o[2], od[2]; zero_o(o);
    float m = -1e30f, lsum = 0.f, md = 0.f, ld = 0.f;
    flash_tiles<MODE_MOBA, true>(lds, hb + (size_t)b * SEQ * NIN + C_MBK + 64 * hd, hb + (size_t)b * SEQ * NIN + C_MBV + 64 * hd, NIN, 0, 4 * qb + 3, qf, qpos, q0w,
                           (unsigned long long)bm, 1.0f, m, lsum, o, md, ld, od, tid, lane, st0);
    const float inv = 1.0f / lsum;
#pragma unroll
    for (int i = 0; i < 16; ++i) { o[0][i] *= inv; o[1][i] *= inv; }
    store_o((bf16_t*)(P.ws + WS_O) + ((size_t)2 * TOK + (size_t)b * SEQ + qpos) * 256 + 64 * hd, o, h);
}

constexpr int NSA_IMP = 73728, NSA_SELM = NSA_IMP + 65536;
DI void nsa_unit(const Params& P, int l, LAS char* lds, int b, int qt, int tid, int wave, int lane) {
    const bf16_t* hb = (const bf16_t*)(P.ws + WS_H);
    const int r = lane & 31, h = lane >> 5, hd = wave & 3, qh = wave >> 2, q0w = 64 * qt + 32 * qh, qpos = q0w + r;
    const bf16_t* hrow = hb + (size_t)(b * SEQ + qpos) * NIN;
    bf16x8 qf[4]; load_q(qf, hrow + C_NSQ + 64 * hd, h);
    norm_rope_q<false>(qf, P.in[9] + (size_t)l * 64, 0.125f * LOG2E, qpos, h, lane);
    const float g_c = sigmoidf_(bf2f(hrow[C_NSG + 0 + hd])), g_s = sigmoidf_(bf2f(hrow[C_NSG + 4 + hd])), g_w = sigmoidf_(bf2f(hrow[C_NSG + 8 + hd]));
    const float c = 1.0f;
    LAS char* kcL = lds; LAS char* vcL = lds + 256 * KP;
    LAS float* impH = (LAS float*)(lds + NSA_IMP);
    const int nst = ((4 * qt + 2) >> 5) + 1;
    {
        const bf16_t* kcg = (const bf16_t*)(P.ws + WS_KC) + (size_t)b * 256 * 64; const bf16_t* vcg = (const bf16_t*)(P.ws + WS_VC) + (size_t)b * 256 * 64;
        const int lim = 32 * nst * 8;
        u32x4 kk[4], vv[4];
#pragma unroll
        for (int it = 0; it < 4; ++it) { const int ch = tid + 512 * it; if (ch < lim) { kk[it] = *(const u32x4*)(kcg + (size_t)ch * 8); vv[it] = *(const u32x4*)(vcg + (size_t)ch * 8); } }
#pragma unroll
        for (int it = 0; it < 4; ++it) { const int ch = tid + 512 * it, key = ch >> 3, cc = ch & 7; if (ch < lim) { *(LAS u32x4*)(kcL + key * KP + 16 * cc) = kk[it]; *(LAS u32x4*)(vcL + key * KP + 16 * cc) = vv[it]; } }
    }
    __syncthreads();
    f32x16 otot[2], o[2]; zero_o(otot); zero_o(o);
    float m = -1e30f, lsum = 0.f;
    for (int st = 0; st < nst; ++st) {
        const f32x16 s = qk_rows<0, 4>(kcL, 32 * st, qf, r, h);
        float t[16], mx = -1e30f;
#pragma unroll
        for (int i = 0; i < 16; ++i) { const int n = 32 * st + (i & 3) + 8 * (i >> 2) + 4 * h; const bool ok = (16 * n + 31 <= qpos); t[i] = ok ? s[i] * c : -1e30f; mx = fmaxf(mx, t[i]); }
        mx = fmaxf(mx, shx32(mx, lane));
        const float mn = fmaxf(m, mx), alpha = ex2(m - mn);
        float rs = 0.f;
#pragma unroll
        for (int i = 0; i < 16; ++i) rs += (t[i] > -1e29f) ? ex2(t[i] - mn) : 0.f;
        rs += shx32(rs, lane);
        lsum = lsum * alpha + rs; m = mn;
    }
    const float linv = lsum > 0.f ? 1.0f / lsum : 0.f;
    float prevpc3 = 0.f;
    for (int st = 0; st < nst; ++st) {
        const f32x16 s = qk_rows<0, 4>(kcL, 32 * st, qf, r, h);
        float p[16];
#pragma unroll
        for (int i = 0; i < 16; ++i) { const int n = 32 * st + (i & 3) + 8 * (i >> 2) + 4 * h; const bool ok = (16 * n + 31 <= qpos); p[i] = ok ? ex2(s[i] * c - m) * linv : 0.f; }
        float pc[4];
#pragma unroll
        for (int g = 0; g < 4; ++g) pc[g] = shx32(p[4 * g + 3], lane);
#pragma unroll
        for (int g = 0; g < 4; ++g) {
            const float a = 2.0f * ((p[4 * g] + p[4 * g + 1]) + p[4 * g + 2]) + p[4 * g + 3];
            const float pred = (h == 1) ? pc[g] : (g > 0 ? pc[g > 0 ? g - 1 : 0] : prevpc3);
            impH[(hd * 64 + 32 * qh + r) * 64 + 8 * st + 2 * g + h] = a + pred;
        }
        prevpc3 = pc[3];
        bf16x8 pf[2]; pack_p(p, pf);
        pv_rows(o, vcL, 32 * st, pf, lane);
    }
#pragma unroll
    for (int i = 0; i < 16; ++i) { otot[0][i] = g_c * o[0][i]; otot[1][i] = g_c * o[1][i]; }
    __syncthreads();
    Stage2 stS; flash_prefetch(stS, hb + (size_t)b * SEQ * NIN + C_KS, hb + (size_t)b * SEQ * NIN + C_VS, NIN, 0, qt, tid);
    {
        LAS float* impS = (LAS float*)lds;
        LAS unsigned long long* selm = (LAS unsigned long long*)(lds + NSA_SELM);
        const int q = tid >> 3, s8 = tid & 7;
        if (qt <= 15) { if (s8 == 0) selm[q] = (2ull << qt) - 1ull; }
        else {
#pragma unroll
            for (int e = 0; e < 8; ++e) { const int J = 8 * s8 + e; impS[q * 65 + J] = ((impH[(0 * 64 + q) * 64 + J] + impH[(1 * 64 + q) * 64 + J]) + impH[(2 * 64 + q) * 64 + J]) + impH[(3 * 64 + q) * 64 + J]; }
            __syncthreads();
            unsigned bits = 0;
#pragma unroll
            for (int e = 0; e < 8; ++e) {
                const int J = 8 * s8 + e;
                if (J >= 1 && J <= qt - 2) {
                    const float v = impS[q * 65 + J]; int cnt = 0;
                    for (int J2 = 1; J2 <= qt - 2; ++J2) { const float v2 = impS[q * 65 + J2]; cnt += (v2 > v || (v2 == v && J2 < J)) ? 1 : 0; }
                    if (cnt < 13) bits |= 1u << e;
                }
            }
            unsigned lo = (s8 < 4) ? (bits << (8 * s8)) : 0u, hi = (s8 >= 4) ? (bits << (8 * (s8 - 4))) : 0u;
            lo |= shxu(lo, 1, lane); lo |= shxu(lo, 2, lane); lo |= shxu(lo, 4, lane);
            hi |= shxu(hi, 1, lane); hi |= shxu(hi, 2, lane); hi |= shxu(hi, 4, lane);
            if (s8 == 0) selm[q] = ((unsigned long long)hi << 32) | (unsigned long long)lo | 1ull | (1ull << (qt - 1)) | (1ull << qt);
        }
    }
    __syncthreads();
    const unsigned long long sel = ((LAS const unsigned long long*)(lds + NSA_SELM))[32 * qh + r];
    float md = 0.f, ld = 0.f; f32x16 od[2];
    LAS float* stash = (LAS float*)(lds + NSA_IMP) + wave * 2048 + lane;
#pragma unroll
    for (int i = 0; i < 16; ++i) { stash[i * 64] = otot[0][i]; stash[(16 + i) * 64] = otot[1][i]; }
    zero_o(o); m = -1e30f; lsum = 0.f;
    flash_tiles<MODE_NSEL, true>(lds, hb + (size_t)b * SEQ * NIN + C_KS, hb + (size_t)b * SEQ * NIN + C_VS, NIN, 0, qt, qf, qpos, q0w, sel, c, m, lsum, o, md, ld, od, tid, lane, stS);
    { const float f = g_s / lsum;
#pragma unroll
      for (int i = 0; i < 16; ++i) { stash[i * 64] += f * o[0][i]; stash[(16 + i) * 64] += f * o[1][i]; } }
    zero_o(o); m = -1e30f; lsum = 0.f;
    flash_tiles<MODE_NWIN>(lds, hb + (size_t)b * SEQ * NIN + C_KW, hb + (size_t)b * SEQ * NIN + C_VW, NIN, qt > 8 ? qt - 8 : 0, qt, qf, qpos, q0w, 0ull, c, m, lsum, o, md, ld, od, tid, lane, stS);
    { const float f = g_w / lsum;
#pragma unroll
      for (int i = 0; i < 16; ++i) { otot[0][i] = stash[i * 64] + f * o[0][i]; otot[1][i] = stash[(16 + i) * 64] + f * o[1][i]; } }
    store_o((bf16_t*)(P.ws + WS_O) + ((size_t)3 * TOK + (size_t)b * SEQ + qpos) * 256 + 64 * hd, otot, h);
}

#define UNIT_LOOP(BODY) _Pragma("unroll 1") for (int k = 0; k * G < 512; ++k) { const int j = k * G + ((k & 1) ? (G - 1 - cblk) : cblk); if (j >= 512) continue; __syncthreads(); \
    int tid_ = wave_s * 64 + fresh_lane(); const int tid = tid_, lane = tid & 63, wave = wave_s; (void)tid; \
    const int bh = j & 31, qb = 15 - (j >> 5), b = bh >> 2, hd = bh & 3; (void)qb; (void)b; (void)hd; BODY; }
DI void attn_phase(const Params& P, int l, LAS char* lds, int G, int cblk, const int wave_s) {
    if (PH_MASK & 16u) { UNIT_LOOP(nsa_unit(P, l, lds, j & 7, 63 - (j >> 3), tid, wave, lane)) }
    if (PH_MASK & 32u) { UNIT_LOOP(diff_unit(P, l, lds, b, hd, qb, tid, wave, lane)) }
    if (PH_MASK & 64u) { UNIT_LOOP(moba_unit(P, l, lds, b, hd, qb, tid, wave, lane)) }
    if (PH_MASK & 128u) { UNIT_LOOP(sb_unit(P, lds, b, hd, qb, wave, lane)) }
}
__global__ void __launch_bounds__(NWAVES * 64 LB2) fwd_kernel(Params P) {
    extern __shared__ __attribute__((aligned(16))) unsigned char lds_raw[];
    cg::grid_group grid = cg::this_grid();
    LAS unsigned char* lds = (LAS unsigned char*)lds_raw;
    const int G = gridDim.x, bx = blockIdx.x;
    const int wave_s = __builtin_amdgcn_readfirstlane((int)threadIdx.x >> 6);
    if (threadIdx.x < 16) ((LAS unsigned*)(lds + LDS_BYTES - 64))[threadIdx.x] = 0u;
    __syncthreads();
    const XcdBarrier xbar = xcd_barrier_post((unsigned*)P.ws, (volatile LAS unsigned*)(lds + LDS_BYTES - 64));
    const int vcu = (G % 8 == 0) ? (bx % 8) * (G / 8) + bx / 8 : bx;
    const int NGW = G * NWAVES;
#define FRESH_IDS() int tid_ = wave_s * 64 + fresh_lane(); const int tid = tid_, lane = tid & 63, wave = __builtin_amdgcn_readfirstlane(tid >> 6), gw = vcu * NWAVES + wave; (void)gw; (void)lane; (void)tid
    bf16_t* XN = (bf16_t*)(P.ws + WS_XN); bf16_t* HB = (bf16_t*)(P.ws + WS_H); bf16_t* OB = (bf16_t*)(P.ws + WS_O); bf16_t* TB = (bf16_t*)(P.ws + WS_T);
    bf16_t* MG = (bf16_t*)(P.ws + WS_O); float* X1 = (float*)(P.ws + WS_X1); bf16_t* AB = (bf16_t*)(P.ws + WS_A);

    { FRESH_IDS(); if (PH_MASK & 1u) prologue_phase(P, lds, gw, NGW, wave, lane); }
    { FRESH_IDS(); rms_phase(P.in[0], P.in[1], XN, gw, NGW, lane); }
    if (P.ws == nullptr) grid.sync();
    xcd_barrier(xbar, wave_s);
#ifdef PROBE_SYNC
#define GSYNC() do { xcd_barrier(xbar, wave_s); xcd_barrier(xbar, wave_s); xcd_barrier(xbar, wave_s); } while (0)
#else
#define GSYNC() xcd_barrier(xbar, wave_s)
#endif
#pragma unroll 1
    for (int l = 0; l < DEPTH; ++l) {
        const float* xin = (l == 0) ? P.in[0] : (const float*)P.out;
        unsigned char* wl = P.ws + WS_W + (size_t)l * WL_STRIDE;
        if (l > 0) { FRESH_IDS(); rms_phase(xin, P.in[1] + (size_t)l * DM, XN, gw, NGW, lane); GSYNC(); }
        {
            pg8::Gemm g{XN, (const bf16_t*)(wl + WL_IN), TOK, NIN, DM}; pg8::StaticOrder S; S.init(TOK, NIN, G, bx);
            pg8::EpiStore E{HB, NIN};
            if (((PH_MASK & 8u) != 0u) & ((GEMM_SEL & 1u) != 0u)) pg8::gemm_phase<pg8::EpiStore, pg8::StaticOrder, true, true>(lds, g, S, E, wave_s);
#ifdef PROBE_GEMM2
            __syncthreads();
            if (((PH_MASK & 8u) != 0u) & ((GEMM_SEL & 1u) != 0u)) pg8::gemm_phase<pg8::EpiStore, pg8::StaticOrder, true, true>(lds, g, S, E, wave_s);
#endif
        }
        GSYNC();
        if (PH_MASK & 2u) { FRESH_IDS(); prep_phase(P, l, lds, G, bx, gw, NGW, wave, lane); }
        GSYNC();
        if (PH_MASK & 4u) { attn_phase(P, l, (LAS char*)lds, G, bx, wave_s); }
#ifdef PROBE_ATTN2
        grid.sync(); attn_phase(P, l, (LAS char*)lds, G, bx, wave_s);
#endif
        GSYNC();
        {
            pg8::Gemm g{OB, (const bf16_t*)(wl + WL_B), 4 * TOK, 4096, 256}; pg8::DiagOrder S{G, bx};
            pg8::EpiT E{TB};
            if (((PH_MASK & 8u) != 0u) & ((GEMM_SEL & 2u) != 0u)) pg8::gemm_phase<pg8::EpiT, pg8::DiagOrder, true, true>(lds, g, S, E, wave_s);
#ifdef PROBE_GEMM2
            __syncthreads();
            if (((PH_MASK & 8u) != 0u) & ((GEMM_SEL & 2u) != 0u)) pg8::gemm_phase<pg8::EpiT, pg8::DiagOrder, true, true>(lds, g, S, E, wave_s);
#endif
        }
        GSYNC();
        {
            pg8::Gemm g{XN, (const bf16_t*)(wl + WL_G), TOK, 4096, DM}; pg8::StaticOrder S; S.init(TOK, 4096, G, bx);
            pg8::EpiMerge E{TB, P.in[14] + (size_t)l * 4 * DM, MG};
            if (((PH_MASK & 8u) != 0u) & ((GEMM_SEL & 4u) != 0u)) pg8::gemm_phase<pg8::EpiMerge, pg8::StaticOrder, true, true>(lds, g, S, E, wave_s);
#ifdef PROBE_GEMM2
            __syncthreads();
            if (((PH_MASK & 8u) != 0u) & ((GEMM_SEL & 4u) != 0u)) pg8::gemm_phase<pg8::EpiMerge, pg8::StaticOrder, true, true>(lds, g, S, E, wave_s);
#endif
        }
        GSYNC();
        {
            pg8::Gemm g{MG, (const bf16_t*)(wl + WL_O), TOK, DM, DM}; pg8::StaticOrder S; S.init(TOK, DM, G, bx);
            pg8::EpiResid E{xin, X1};
            if (((PH_MASK & 8u) != 0u) & ((GEMM_SEL & 8u) != 0u)) pg8::gemm_phase<pg8::EpiResid, pg8::StaticOrder, true, true>(lds, g, S, E, wave_s);
#ifdef PROBE_GEMM2
            __syncthreads();
            if (((PH_MASK & 8u) != 0u) & ((GEMM_SEL & 8u) != 0u)) pg8::gemm_phase<pg8::EpiResid, pg8::StaticOrder, true, true>(lds, g, S, E, wave_s);
#endif
        }
        GSYNC();
        { FRESH_IDS(); rms_phase(X1, P.in[17] + (size_t)l * DM, XN, gw, NGW, lane); }
        GSYNC();
        {
            pg8::Gemm g{XN, (const bf16_t*)(wl + WL_GU), TOK, NGU, DM}; pg8::StaticOrder S; S.init(TOK, NGU, G, bx);
            pg8::EpiSwiGLU E{AB};
            if (((PH_MASK & 8u) != 0u) & ((GEMM_SEL & 16u) != 0u)) pg8::gemm_phase<pg8::EpiSwiGLU, pg8::StaticOrder, true, true>(lds, g, S, E, wave_s);
#ifdef PROBE_GEMM2
            __syncthreads();
            if (((PH_MASK & 8u) != 0u) & ((GEMM_SEL & 16u) != 0u)) pg8::gemm_phase<pg8::EpiSwiGLU, pg8::StaticOrder, true, true>(lds, g, S, E, wave_s);
#endif
        }
        GSYNC();
        {
            pg8::Gemm g{AB, (const bf16_t*)(wl + WL_D), TOK, DM, FF}; pg8::StaticOrder S; S.init(TOK, DM, G, bx);
            pg8::EpiResid E{X1, P.out};
            if (((PH_MASK & 8u) != 0u) & ((GEMM_SEL & 32u) != 0u)) pg8::gemm_phase<pg8::EpiResid, pg8::StaticOrder, true, true>(lds, g, S, E, wave_s);
#ifdef PROBE_GEMM2
            __syncthreads();
            if (((PH_MASK & 8u) != 0u) & ((GEMM_SEL & 32u) != 0u)) pg8::gemm_phase<pg8::EpiResid, pg8::StaticOrder, true, true>(lds, g, S, E, wave_s);
#endif
        }
        if (l + 1 < DEPTH) GSYNC();
    }
}

extern "C" void kernel_launch(void* const* d_in, const int* in_sizes, int n_in, void* d_out, int out_size, void* d_ws, size_t ws_size, hipStream_t stream) {
    static int grid = 0;
    if (grid == 0) {
        if (n_in != 21 || ws_size < WS_END) { fprintf(stderr, "kernel_launch: unexpected n_in %d / ws %zu\n", n_in, ws_size); grid = -1; return; }
        int dev = 0, cus = 0, per_cu = 0;
        (void)hipGetDevice(&dev); (void)hipDeviceGetAttribute(&cus, hipDeviceAttributeMultiprocessorCount, dev);
        (void)hipFuncSetAttribute((const void*)fwd_kernel, hipFuncAttributeMaxDynamicSharedMemorySize, LDS_BYTES);
        (void)hipOccupancyMaxActiveBlocksPerMultiprocessor(&per_cu, (const void*)fwd_kernel, NWAVES * 64, LDS_BYTES);
        if (per_cu < 1) per_cu = 1;
        grid = cus * 1;
        (void)hipGetLastError();
    }
    if (grid < 0) return;
    if (hipMemsetAsync(d_ws, 0, 16384, stream) != hipSuccess) { fprintf(stderr, "kernel_launch: memset of the barrier words failed\n"); return; }
    Params p{};
    for (int i = 0; i < 21; ++i) p.in[i] = (const float*)d_in[i];
    p.out = (float*)d_out; p.ws = (unsigned char*)d_ws;
    void* args[] = {&p};
    hipError_t e = hipLaunchCooperativeKernel((const void*)fwd_kernel, dim3(grid), dim3(NWAVES * 64), args, LDS_BYTES, stream);
    if (e != hipSuccess) fprintf(stderr, "cooperative launch failed: %s (grid %d)\n", hipGetErrorString(e), grid);
}
```

```cpp
#include <hip/hip_runtime.h>
#include <hip/hip_cooperative_groups.h>
#include <cstdio>
#include <cstdint>
namespace cg = cooperative_groups;
#define PG8_LAS __attribute__((address_space(3)))
#define LAS __attribute__((address_space(3)))
#define DI __device__ __forceinline__
#ifndef GEMM_SEL
#define GEMM_SEL 0xffu
#endif
#ifndef LB2
#define LB2
#endif
#ifndef PH_MASK
#define PH_MASK 0xffffffffu
#endif
__device__ __forceinline__ int fresh_lane() { int l; asm volatile("v_mbcnt_lo_u32_b32 %0, -1, 0\n\tv_mbcnt_hi_u32_b32 %0, -1, %0" : "=v"(l)); return l; }
#ifndef DIFF_MERGED
#define DIFF_MERGED 0
#endif
#ifndef PIPE64
#define PIPE64 1
#endif
namespace pg8 {
typedef unsigned short bf16_t;
typedef short bf16x8 __attribute__((ext_vector_type(8)));
typedef float f32x4 __attribute__((ext_vector_type(4)));
typedef unsigned u32x4 __attribute__((ext_vector_type(4)));
constexpr int BM = 256, BK = 64, HALF = 128, HTB = HALF * BK * 2  , STAGE_BYTES = 8 * HTB, NXCD = 8, WGM = 8;

__host__ __device__ __forceinline__ int lds_byte(int r, int c) { const int st = (r >> 4) * 2 + (c >> 5), rr = r & 15, cc = c & 31, ob = rr * 64 + cc * 2; return st * 1024 + (ob ^ (((ob >> 9) & 1) << 5)); }
__host__ __device__ __forceinline__ void stage_rc(int b, int& R, int& C) { const int st = b / 1024, sb = b % 1024, swz = sb ^ (((sb >> 9) & 1) << 5); R = (st >> 1) * 16 + swz / 64; C = (st & 1) * 32 + (swz % 64) / 2; }
__host__ __device__ __forceinline__ int perm32(int rho) { const int n = rho >> 4, i = rho & 15; return 8 * (i >> 2) + 4 * n + (i & 3); }

struct Unit { int pm, pn; };
struct Gemm { const bf16_t* A; const bf16_t* Bt; int M, N, K; };

struct StaticOrder {
    int nM, nN, nwg, G, c;
    __host__ __device__ void init(int M, int N, int G_, int c_) { nM = M / BM; nN = N / BM; nwg = nM * nN; G = G_; c = c_; }
    __host__ __device__ bool next(int i, Unit& u) const {
        const long L = (long)i * G + c; if (L >= nwg) return false;
        int wgid = (int)L; { const int q = nwg / NXCD, r = nwg % NXCD, xcd = wgid % NXCD, off = wgid / NXCD; wgid = (xcd < r ? xcd * (q + 1) : r * (q + 1) + (xcd - r) * q) + off; }
        const int nig = WGM * nN, gid = wgid / nig, fm = gid * WGM, gsz = (nM - fm) < WGM ? (nM - fm) : WGM;
        u.pm = fm + ((wgid % nig) % gsz); u.pn = (wgid % nig) / gsz; return true;
    }
    __device__ __forceinline__ void a_ready(const Unit&) const {}
    __device__ __forceinline__ void done(const Unit&) const {}
};
__device__ __forceinline__ unsigned cvt_pk_bf16(float lo, float hi) { unsigned r; asm volatile("v_cvt_pk_bf16_f32 %0, %1, %2" : "=v"(r) : "v"(lo), "v"(hi)); return r; }
template <class Epi, class Sched, bool ALIGN_EPI = false, bool SP2 = false>
__device__ __forceinline__ void gemm_phase(PG8_LAS unsigned char* lds, const Gemm g, const Sched& S, const Epi& E, const int wave_s) {
    int tid_ = wave_s * 64 + fresh_lane();
    const int tid = tid_, wid = __builtin_amdgcn_readfirstlane(tid >> 6), lane = tid & 63, wr = wid >> 2, wc = wid & 3, fr = lane & 15, fq = lane >> 4;
    int K_ = g.K; asm volatile("" : "+s"(K_));
    const int K = K_, nt = K / BK;
    unsigned voffA[2], voffB[2];
#pragma unroll
    for (int i = 0; i < 2; ++i) { int R, C; stage_rc(tid * 16 + i * 8192, R, C); const int Rb = Epi::PERM ? ((R & ~31) + perm32(R & 31)) : R;
        voffA[i] = (unsigned)(R * K + C) * 2u; voffB[i] = (unsigned)(Rb * K + C) * 2u; }
    const size_t kstep = (size_t)(BK * 2);
    const size_t hstep = (size_t)HALF * K * 2;
    const size_t tstep = 2 * hstep;
    const unsigned ldsw = (unsigned)wid * 1024u;
    const int aoff = lds_byte(wr * 64 + fr, fq * 8), boff = lds_byte(wc * 32 + fr, fq * 8);
#define PG8_SA(b, h) (((b) * 2 + (h)) * HTB)
#define PG8_SB(b, h) ((4 + (b) * 2 + (h)) * HTB)
#define PG8_STAGE(bufoff, gbase, voff) do { _Pragma("unroll") for (int _i = 0; _i < 2; ++_i) \
        __builtin_amdgcn_global_load_lds((const unsigned*)((const char*)(gbase) + (voff)[_i]), (PG8_LAS unsigned*)(lds + (bufoff) + ldsw + _i * 8192), 16, 0, 0); } while (0)
#define PG8_LDA(dst, b, h) do { _Pragma("unroll") for (int m = 0; m < 4; ++m) _Pragma("unroll") for (int k = 0; k < 2; ++k) dst[m][k] = *(const PG8_LAS bf16x8*)(lds + PG8_SA(b, h) + aoff + m * 2048 + k * 1024); } while (0)
#define PG8_LDB(dst, b, h) do { _Pragma("unroll") for (int n = 0; n < 2; ++n) _Pragma("unroll") for (int k = 0; k < 2; ++k) dst[n][k] = *(const PG8_LAS bf16x8*)(lds + PG8_SB(b, h) + boff + n * 2048 + k * 1024); } while (0)
#define PG8_MMA(ai, bj, At, Bt) do { __builtin_amdgcn_s_setprio(1); _Pragma("unroll") for (int m = 0; m < 4; ++m) _Pragma("unroll") for (int n = 0; n < 2; ++n) _Pragma("unroll") for (int k = 0; k < 2; ++k) \
        acc[ai][bj][m][n] = __builtin_amdgcn_mfma_f32_16x16x32_bf16(Bt[n][k], At[m][k], acc[ai][bj][m][n], 0, 0, 0); __builtin_amdgcn_s_setprio(0); } while (0)
#define PG8_WAIT_V(n) asm volatile("s_waitcnt vmcnt(" #n ")" ::: "memory")
#define PG8_WAIT_L(n) asm volatile("s_waitcnt lgkmcnt(" #n ")" ::: "memory")
#define PG8_BAR __builtin_amdgcn_s_barrier()
#define PG8_SCHED __builtin_amdgcn_sched_barrier(0)
    Unit cur, nxt; int ui = 0;
    if (!S.next(0, cur)) return;
    f32x4 acc[2][2][4][2];
#pragma unroll
    for (int a = 0; a < 2; ++a)
#pragma unroll
        for (int b = 0; b < 2; ++b)
#pragma unroll
            for (int m = 0; m < 4; ++m)
#pragma unroll
                for (int n = 0; n < 2; ++n) acc[a][b][m][n] = (f32x4){0.f, 0.f, 0.f, 0.f};
    bf16x8 At[4][2], B0[2][2], B1[2][2];
    const char* cA = (const char*)g.A + (size_t)cur.pm * tstep; const char* cB = (const char*)g.Bt + (size_t)cur.pn * tstep;
    S.a_ready(cur);
    if constexpr (SP2) {
        PG8_STAGE(PG8_SB(0, 0), cB, voffB); PG8_STAGE(PG8_SB(0, 1), cB + hstep, voffB); PG8_STAGE(PG8_SA(0, 0), cA, voffA); PG8_STAGE(PG8_SA(0, 1), cA + hstep, voffA);
        if (wr == 1) PG8_BAR;
        PG8_WAIT_V(2); PG8_BAR;
        PG8_STAGE(PG8_SB(1, 0), cB + kstep, voffB); PG8_STAGE(PG8_SA(1, 0), cA + kstep, voffA); PG8_STAGE(PG8_SB(1, 1), cB + hstep + kstep, voffB);
        PG8_WAIT_V(6); PG8_BAR;
    } else {
        PG8_STAGE(PG8_SB(0, 0), cB, voffB); PG8_STAGE(PG8_SA(0, 0), cA, voffA); PG8_STAGE(PG8_SB(0, 1), cB + hstep, voffB); PG8_STAGE(PG8_SA(0, 1), cA + hstep, voffA);
        if (wr == 1) PG8_BAR;
        PG8_WAIT_V(4); PG8_BAR;
        PG8_STAGE(PG8_SB(1, 0), cB + kstep, voffB); PG8_STAGE(PG8_SA(1, 0), cA + kstep, voffA); PG8_STAGE(PG8_SB(1, 1), cB + hstep + kstep, voffB);
        PG8_WAIT_V(6); PG8_BAR;
    }
    for (;;) {
        const bool has_next = S.next(ui + 1, nxt);
        const char* nA = has_next ? (const char*)g.A + (size_t)nxt.pm * tstep : cA; const char* nB = has_next ? (const char*)g.Bt + (size_t)nxt.pn * tstep : cB;
        for (int t = 0; t < nt; t += 2) {
            const bool last = (t == nt - 2);
            const char* a1 = cA + (size_t)(t + 1) * kstep;
            const char* a2 = last ? nA : cA + (size_t)(t + 2) * kstep; const char* b2 = last ? nB : cB + (size_t)(t + 2) * kstep;
            const char* a3 = a2 + kstep; const char* b3 = b2 + kstep;
            if (last && has_next) S.a_ready(nxt);
            if constexpr (SP2) {
            PG8_LDB(B0, 0, 0); PG8_LDB(B1, 0, 1); PG8_SCHED; PG8_LDA(At, 0, 0); PG8_STAGE(PG8_SA(1, 1), a1 + hstep, voffA);
            PG8_WAIT_V(8); PG8_WAIT_L(0); PG8_BAR; PG8_MMA(0, 0, At, B0); PG8_MMA(0, 1, At, B1); PG8_BAR; PG8_SCHED;
            PG8_LDA(At, 0, 1); PG8_STAGE(PG8_SB(0, 0), b2, voffB); PG8_STAGE(PG8_SB(0, 1), b2 + hstep, voffB); PG8_STAGE(PG8_SA(0, 0), a2, voffA);
            PG8_WAIT_V(8); PG8_WAIT_L(0); PG8_BAR; PG8_MMA(1, 0, At, B0); PG8_MMA(1, 1, At, B1); PG8_BAR; PG8_SCHED;
            PG8_LDB(B0, 1, 0); PG8_LDB(B1, 1, 1); PG8_SCHED; PG8_LDA(At, 1, 0); PG8_STAGE(PG8_SA(0, 1), a2 + hstep, voffA);
            PG8_WAIT_V(8); PG8_WAIT_L(0); PG8_BAR; PG8_MMA(0, 0, At, B0); PG8_MMA(0, 1, At, B1); PG8_BAR; PG8_SCHED;
            PG8_LDA(At, 1, 1); PG8_STAGE(PG8_SB(1, 0), b3, voffB); PG8_STAGE(PG8_SB(1, 1), b3 + hstep, voffB); PG8_STAGE(PG8_SA(1, 0), a3, voffA);
            PG8_WAIT_V(8); PG8_WAIT_L(0); PG8_BAR; PG8_MMA(1, 0, At, B0); PG8_MMA(1, 1, At, B1); PG8_BAR; PG8_SCHED;
            } else {
            PG8_LDB(B0, 0, 0); PG8_SCHED; PG8_LDA(At, 0, 0); PG8_STAGE(PG8_SA(1, 1), a1 + hstep, voffA);
            PG8_WAIT_L(8); PG8_BAR; PG8_WAIT_L(0); PG8_MMA(0, 0, At, B0); PG8_BAR; PG8_SCHED;
            PG8_LDB(B1, 0, 1); PG8_STAGE(PG8_SB(0, 0), b2, voffB);
            PG8_BAR; PG8_WAIT_L(0); PG8_MMA(0, 1, At, B1); PG8_BAR;
            PG8_LDA(At, 0, 1); PG8_STAGE(PG8_SA(0, 0), a2, voffA);
            PG8_BAR; PG8_WAIT_L(0); PG8_MMA(1, 0, At, B0); PG8_BAR; PG8_SCHED;
            PG8_STAGE(PG8_SB(0, 1), b2 + hstep, voffB);
            PG8_WAIT_V(6); PG8_BAR; PG8_MMA(1, 1, At, B1); PG8_BAR;
            PG8_LDB(B0, 1, 0); PG8_SCHED; PG8_LDA(At, 1, 0); PG8_STAGE(PG8_SA(0, 1), a2 + hstep, voffA);
            PG8_WAIT_L(8); PG8_BAR; PG8_WAIT_L(0); PG8_MMA(0, 0, At, B0); PG8_BAR; PG8_SCHED;
            PG8_LDB(B1, 1, 1); PG8_STAGE(PG8_SB(1, 0), b3, voffB);
            PG8_BAR; PG8_WAIT_L(0); PG8_MMA(0, 1, At, B1); PG8_BAR;
            PG8_LDA(At, 1, 1); PG8_STAGE(PG8_SA(1, 0), a3, voffA);
            PG8_BAR; PG8_WAIT_L(0); PG8_MMA(1, 0, At, B0); PG8_BAR; PG8_SCHED;
            PG8_STAGE(PG8_SB(1, 1), b3 + hstep, voffB);
            PG8_WAIT_V(6); PG8_BAR; PG8_MMA(1, 1, At, B1); PG8_BAR;
            }
        }
        if constexpr (ALIGN_EPI) { if (wr == 0) PG8_BAR; }
        if constexpr (!Epi::AFTER_DRAIN) { E(acc, cur, wr, wc, fr, fq); S.done(cur); }
        if (!has_next) break;
#pragma unroll
        for (int a = 0; a < 2; ++a)
#pragma unroll
            for (int b = 0; b < 2; ++b)
#pragma unroll
                for (int m = 0; m < 4; ++m)
#pragma unroll
                    for (int n = 0; n < 2; ++n) acc[a][b][m][n] = (f32x4){0.f, 0.f, 0.f, 0.f};
        cur = nxt; cA = nA; cB = nB; ++ui;
        if constexpr (ALIGN_EPI) { if (wr == 1) PG8_BAR; }
    }
    PG8_WAIT_V(0);
    if constexpr (!ALIGN_EPI) { if (wr == 0) PG8_BAR; }
    PG8_BAR;
    if constexpr (Epi::AFTER_DRAIN) { E.fused(acc, cur, wr, wc, fr, fq, lds, wid, lane); S.done(cur); }
#undef PG8_SA
#undef PG8_SB
#undef PG8_STAGE
#undef PG8_LDA
#undef PG8_LDB
#undef PG8_MMA
#undef PG8_WAIT_V
#undef PG8_WAIT_L
#undef PG8_BAR
#undef PG8_SCHED
}
}
typedef unsigned short bf16_t;
typedef short bf16x8 __attribute__((ext_vector_type(8)));
typedef short s16x4 __attribute__((ext_vector_type(4)));
typedef float f32x4 __attribute__((ext_vector_type(4)));
typedef float f32x16 __attribute__((ext_vector_type(16)));
typedef unsigned u32x4 __attribute__((ext_vector_type(4)));
typedef unsigned u32x2 __attribute__((ext_vector_type(2)));
typedef float f32x2_t __attribute__((ext_vector_type(2)));
typedef __bf16 bf16x2_t __attribute__((ext_vector_type(2)));

constexpr int NB = 8, SEQ = 4096, TOK = NB * SEQ, DM = 1024, NIN = 3072, INC = 2956, FF = 2816, NGU = 5632, DEPTH = 2;
constexpr int C_SBQ = 0, C_SBK = 256, C_SBV = 512, C_DFQ = 768, C_DFK = 1024, C_DFV = 1280, C_MBQ = 1536, C_MBK = 1792, C_MBV = 2048,
              C_NSQ = 2304, C_KC = 2560, C_VC = 2624, C_KS = 2688, C_VS = 2752, C_KW = 2816, C_VW = 2880, C_NSG = 2944;
constexpr size_t MiB = 1u << 20;
constexpr size_t WS_KMEAN = 71 * MiB, WS_KC = 262144, WS_VC = 524288, WS_CWT = 1 * MiB, WS_W = 2 * MiB;
constexpr size_t WL_IN = 0, WL_G = 6 * MiB, WL_B = 14 * MiB, WL_O = 16 * MiB, WL_GU = 18 * MiB, WL_D = 29 * MiB, WL_STRIDE = 34 * MiB + 512 * 1024;
constexpr size_t WS_XN = 72 * MiB, WS_O = 136 * MiB, WS_H = 200 * MiB, WS_X1 = 200 * MiB, WS_T = 200 * MiB, WS_A = 328 * MiB, WS_END = 504 * MiB;
constexpr int LDS_BYTES = 147456;
constexpr int NWAVES = 8;
constexpr float RMS_EPS = 1e-6f;

DI unsigned cvtpk(float lo, float hi) { f32x2_t v = {lo, hi}; bf16x2_t b = __builtin_convertvector(v, bf16x2_t); return __builtin_bit_cast(unsigned, b); }
DI float bf2f(unsigned short u) { return __builtin_bit_cast(float, (unsigned)u << 16); }
DI float bflo(unsigned u) { return __builtin_bit_cast(float, u << 16); }
DI float bfhi(unsigned u) { return __builtin_bit_cast(float, u & 0xffff0000u); }
DI float sigmoidf_(float x) { return __builtin_amdgcn_rcpf(1.0f + __builtin_amdgcn_exp2f(x * -1.4426950408889634f)); }


DI float shx(float v, int m, int lane) { return __builtin_bit_cast(float, __builtin_amdgcn_ds_bpermute((lane ^ m) << 2, __builtin_bit_cast(int, v))); }
DI unsigned shxu(unsigned v, int m, int lane) { return (unsigned)__builtin_amdgcn_ds_bpermute((lane ^ m) << 2, (int)v); }
DI float shx32(float v, int lane) {
    const unsigned u = __builtin_bit_cast(unsigned, v); auto rr = __builtin_amdgcn_permlane32_swap(u, u, false, false);
    return __builtin_bit_cast(float, (lane & 32) ? rr[0] : rr[1]); }

namespace pg8 {
struct EpiStore {
    static constexpr bool PERM = true, AFTER_DRAIN = false;
    bf16_t* O; int ldc;
    DI void operator()(const f32x4 (&acc)[2][2][4][2], const Unit& u, int wr, int wc, int fr, int fq) const {
        const int row0 = u.pm * BM + wr * 64 + fr, col0 = u.pn * BM + wc * 32 + 8 * fq;
#pragma unroll
        for (int ai = 0; ai < 2; ++ai)
#pragma unroll
            for (int m = 0; m < 4; ++m) { bf16_t* rowp = O + (size_t)(row0 + ai * HALF + m * 16) * ldc + col0;
#pragma unroll
                for (int bj = 0; bj < 2; ++bj) { const f32x4 v0 = acc[ai][bj][m][0], v1 = acc[ai][bj][m][1];
                    u32x4 w; w.x = cvtpk(v0[0], v0[1]); w.y = cvtpk(v0[2], v0[3]); w.z = cvtpk(v1[0], v1[1]); w.w = cvtpk(v1[2], v1[3]);
                    *(u32x4*)(rowp + bj * HALF) = w; } }
    }
};
struct EpiT {
    static constexpr bool PERM = true, AFTER_DRAIN = false;
    bf16_t* O;
    DI void operator()(const f32x4 (&acc)[2][2][4][2], const Unit& u, int wr, int wc, int fr, int fq) const {
        const int br = u.pn >> 2;
        const int row0 = (u.pm - 128 * br) * BM + wr * 64 + fr, col0 = br * 1024 + (u.pn & 3) * BM + wc * 32 + 8 * fq;
#pragma unroll
        for (int ai = 0; ai < 2; ++ai)
#pragma unroll
            for (int m = 0; m < 4; ++m) { bf16_t* rowp = O + (size_t)(row0 + ai * HALF + m * 16) * 4096 + col0;
#pragma unroll
                for (int bj = 0; bj < 2; ++bj) { const f32x4 v0 = acc[ai][bj][m][0], v1 = acc[ai][bj][m][1];
                    u32x4 w; w.x = cvtpk(v0[0], v0[1]); w.y = cvtpk(v0[2], v0[3]); w.z = cvtpk(v1[0], v1[1]); w.w = cvtpk(v1[2], v1[3]);
                    *(u32x4*)(rowp + bj * HALF) = w; } }
    }
};
struct DiagOrder {
    int G, c;
    DI bool next(int i, Unit& u) const {
        const int L = i * G + c; if (L >= 2048) return false;
        const int br = L >> 9, rem = L & 511; u.pm = br * 128 + (rem >> 2); u.pn = br * 4 + (rem & 3); return true;
    }
    DI void a_ready(const Unit&) const {}
    DI void done(const Unit&) const {}
};
struct EpiMerge {
    static constexpr bool PERM = false, AFTER_DRAIN = false;
    const bf16_t* T; const float* bg; bf16_t* O;
    DI void operator()(const f32x4 (&acc)[2][2][4][2], const Unit& u, int wr, int wc, int fr, int fq) const {
        const int row0 = u.pm * BM + wr * 64 + fr, mc0 = u.pn * 64 + wc * 16 + 4 * fq;
        f32x4 bv[4];
#pragma unroll
        for (int i = 0; i < 4; ++i) bv[i] = *(const f32x4*)(bg + i * 1024 + mc0);
#pragma unroll
        for (int ai = 0; ai < 2; ++ai)
#pragma unroll
            for (int m = 0; m < 4; ++m) { const int row = row0 + ai * HALF + m * 16; const bf16_t* tp = T + (size_t)row * 4096 + mc0;
                f32x4 r = {0.f, 0.f, 0.f, 0.f};
#pragma unroll
                for (int i = 0; i < 4; ++i) { const u32x2 tv = *(const u32x2*)(tp + i * 1024); const f32x4 a = acc[ai][i >> 1][m][i & 1] + bv[i];
                    r[0] += sigmoidf_(a[0]) * bflo(tv.x); r[1] += sigmoidf_(a[1]) * bfhi(tv.x); r[2] += sigmoidf_(a[2]) * bflo(tv.y); r[3] += sigmoidf_(a[3]) * bfhi(tv.y); }
                u32x2 w; w.x = cvtpk(r[0], r[1]); w.y = cvtpk(r[2], r[3]);
                *(u32x2*)(O + (size_t)row * 1024 + mc0) = w; }
    }
};
struct EpiResid {
    static constexpr bool PERM = true, AFTER_DRAIN = false;
    const float* base; float* out;
    DI void operator()(const f32x4 (&acc)[2][2][4][2], const Unit& u, int wr, int wc, int fr, int fq) const {
        const int row0 = u.pm * BM + wr * 64 + fr, col0 = u.pn * BM + wc * 32 + 8 * fq;
#pragma unroll
        for (int ai = 0; ai < 2; ++ai)
#pragma unroll
            for (int m = 0; m < 4; ++m) { const size_t off = (size_t)(row0 + ai * HALF + m * 16) * 1024 + col0;
#pragma unroll
                for (int bj = 0; bj < 2; ++bj) {
                    const f32x4 b0 = *(const f32x4*)(base + off + bj * HALF), b1 = *(const f32x4*)(base + off + bj * HALF + 4);
                    *(f32x4*)(out + off + bj * HALF) = b0 + acc[ai][bj][m][0]; *(f32x4*)(out + off + bj * HALF + 4) = b1 + acc[ai][bj][m][1]; } }
    }
};
struct EpiSwiGLU {
    static constexpr bool PERM = true, AFTER_DRAIN = false;
    bf16_t* O;
    DI void operator()(const f32x4 (&acc)[2][2][4][2], const Unit& u, int wr, int wc, int fr, int fq) const {
        const int row0 = u.pm * BM + wr * 64 + fr, col0 = u.pn * 128 + wc * 32 + 8 * fq;
#pragma unroll
        for (int ai = 0; ai < 2; ++ai)
#pragma unroll
            for (int m = 0; m < 4; ++m) { bf16_t* rowp = O + (size_t)(row0 + ai * HALF + m * 16) * FF + col0;
                float r[8];
#pragma unroll
                for (int n = 0; n < 2; ++n)
#pragma unroll
                    for (int e = 0; e < 4; ++e) { const float g = acc[ai][0][m][n][e], up = acc[ai][1][m][n][e]; r[4 * n + e] = g * sigmoidf_(g) * up; }
                u32x4 w; w.x = cvtpk(r[0], r[1]); w.y = cvtpk(r[2], r[3]); w.z = cvtpk(r[4], r[5]); w.w = cvtpk(r[6], r[7]);
                *(u32x4*)rowp = w; }
    }
};
}
#define RLX_AGENT __ATOMIC_RELAXED, __HIP_MEMORY_SCOPE_AGENT
#define XB_TMO      128
#define XB_XCNT(j)  (256  + 64 * (j))
#define XB_XSUB(j)  (1280 + 64 * (j))
#define XB_XGEN(j)  (2304 + 64 * (j))
#define XB_TOP      3328
#define XB_TOPGEN   3392
#define XCD_BAR_WORDS 3456
#define XB_SPIN_CAP (1u << 18)

__device__ __forceinline__ unsigned xb_ld(unsigned* p)              { return __hip_atomic_load(p, __ATOMIC_RELAXED, __HIP_MEMORY_SCOPE_AGENT); }
__device__ __forceinline__ unsigned xb_add(unsigned* p, unsigned v) { return __hip_atomic_fetch_add(p, v, __ATOMIC_RELAXED, __HIP_MEMORY_SCOPE_AGENT); }
__device__ __forceinline__ unsigned xb_xcc_id() { return (unsigned)__builtin_amdgcn_s_getreg((3 << 11) | 20) & 0xFu; }
#define XB_SPIN(cond, bar) do { unsigned _sp = 0; while (cond) { __builtin_amdgcn_s_sleep(1); \
    if ((++_sp & 255u) == 0u) { if (xb_ld(&(bar)[XB_TMO])) break; if (_sp > XB_SPIN_CAP) { atomicAdd(&(bar)[XB_TMO], 1u); break; } } } } while (0)

struct XcdBarrier {
    unsigned* bar; unsigned x;
    volatile LAS unsigned* st;
};

__device__ __forceinline__ XcdBarrier xcd_barrier_post(unsigned* bar, volatile LAS unsigned* st) {
    XcdBarrier b; b.bar = bar; b.x = xb_xcc_id(); b.st = st;
    if (threadIdx.x == 0) (void)xb_add(&bar[XB_XCNT(b.x)], 1u);
    return b;
}
__device__ __forceinline__ void xcd_barrier_complete(unsigned* bar, unsigned x, unsigned& nloc, unsigned& nx) {
    const unsigned G = gridDim.x * gridDim.y * gridDim.z;
    unsigned sum, cnt, mine, sp = 0u;
    for (;;) {
        sum = 0u; cnt = 0u; mine = 0u;
#pragma unroll
        for (unsigned j = 0; j < 16; ++j) { const unsigned c = xb_ld(&bar[XB_XCNT(j)]); sum += c; cnt += (c > 0u) ? 1u : 0u; mine = (j == x) ? c : mine; }
        if (sum == G) break;
        __builtin_amdgcn_s_sleep(1);
        if ((++sp & 255u) == 0u) { if (xb_ld(&bar[XB_TMO])) break; if (sp > XB_SPIN_CAP) { atomicAdd(&bar[XB_TMO], 1u); break; } }
    }
    nloc = mine > 0u ? mine : 1u; nx = cnt > 0u ? cnt : 1u;
}

__device__ __forceinline__ void xcd_barrier(const XcdBarrier& b, const int wave_s) {
    asm volatile("s_waitcnt vmcnt(0)" ::: "memory");
    __syncthreads();
    if (wave_s == 0 && fresh_lane() == 0) {
        unsigned* bar = b.bar;
        __builtin_amdgcn_s_waitcnt(0);
        unsigned nloc = b.st[0], nx = b.st[1];
        if (nloc == 0u) { xcd_barrier_complete(bar, b.x, nloc, nx); b.st[0] = nloc; b.st[1] = nx; }
        const unsigned old = xb_add(&bar[XB_XSUB(b.x)], 1u);
        const unsigned gen = old / nloc;
        if (old + 1u == (gen + 1u) * nloc) {
            __builtin_amdgcn_fence(__ATOMIC_RELEASE, "agent");
            asm volatile("s_waitcnt vmcnt(0)" ::: "memory");
            const unsigned og = xb_add(&bar[XB_TOP], 1u);
            const unsigned tg = og / nx;
            if (og + 1u == (tg + 1u) * nx) xb_add(&bar[XB_TOPGEN], 1u);
            else XB_SPIN(xb_ld(&bar[XB_TOPGEN]) == tg, bar);
            __builtin_amdgcn_fence(__ATOMIC_ACQUIRE, "agent");
            xb_add(&bar[XB_XGEN(b.x)], 1u);
            asm volatile("s_waitcnt vmcnt(0)" ::: "memory");
        } else {
            XB_SPIN(xb_ld(&bar[XB_XGEN(b.x)]) == gen, bar);
            __builtin_amdgcn_fence(__ATOMIC_ACQUIRE, "agent");
            asm volatile("s_waitcnt vmcnt(0)" ::: "memory");
        }
    }
    __syncthreads();
}
struct Params { const float* in[21]; float* out; unsigned char* ws; };

DI float wave_sum(float v, int lane) {
#pragma unroll
    for (int o = 1; o < 32; o <<= 1) v += shx(v, o, lane);
    return v + shx32(v, lane);
}
#define LDS_WAIT() asm volatile("s_waitcnt lgkmcnt(0)" ::: "memory")

DI int rowmap(int mode, int arg, int n) {
    if (mode == 1) { const int pn = n >> 6, w = n & 63; return 256 * pn + 128 * (arg >> 1) + 32 * (w >> 4) + 16 * (arg & 1) + (w & 15); }
    if (mode == 2) { return 256 * (n >> 7) + 128 * arg + (n & 127); }
    return n;
}
struct TJob { const float* W; bf16_t* WT; int K, Nsrc, nblk, mode, arg; };
DI TJob get_job(const Params& P, int l, int j) {
    TJob t; unsigned char* wl = P.ws + WS_W + (size_t)l * WL_STRIDE; t.mode = 0; t.arg = 0;
    if (j == 0) { t.W = P.in[2] + (size_t)l * 1024 * INC; t.WT = (bf16_t*)(wl + WL_IN); t.K = 1024; t.Nsrc = INC; t.nblk = NIN / 32; }
    else if (j < 5) { const int i = j - 1; t.W = P.in[13] + (size_t)(l * 4 + i) * 1024 * 1024; t.WT = (bf16_t*)(wl + WL_G); t.K = 1024; t.Nsrc = 1024; t.nblk = 32; t.mode = 1; t.arg = i; }
    else if (j < 9) { const int i = j - 5; t.W = P.in[15] + (size_t)(l * 4 + i) * 256 * 1024; t.WT = (bf16_t*)(wl + WL_B) + (size_t)i * 1024 * 256; t.K = 256; t.Nsrc = 1024; t.nblk = 32; }
    else if (j == 9) { t.W = P.in[16] + (size_t)l * 1024 * 1024; t.WT = (bf16_t*)(wl + WL_O); t.K = 1024; t.Nsrc = 1024; t.nblk = 32; }
    else if (j < 12) { const int i = j - 10; t.W = P.in[18 + i] + (size_t)l * 1024 * FF; t.WT = (bf16_t*)(wl + WL_GU); t.K = 1024; t.Nsrc = FF; t.nblk = FF / 32; t.mode = 2; t.arg = i; }
    else if (j == 12) { t.W = P.in[20] + (size_t)l * FF * 1024; t.WT = (bf16_t*)(wl + WL_D); t.K = FF; t.Nsrc = 1024; t.nblk = 32; }
    else { const int kv = j - 13; t.W = P.in[12] + (size_t)(l * 2 + kv) * 2048 * 64; t.WT = (bf16_t*)(P.ws + WS_CWT) + (size_t)(l * 2 + kv) * 64 * 2048; t.K = 2048; t.Nsrc = 64; t.nblk = 2; }
    return t;
}
DI void transpose_item(const TJob& t, LAS float* scr, int item, int lane) {
    const int kb = item / t.nblk, nb = item % t.nblk, k0 = 64 * kb, n0 = 32 * nb;
    const int nn = n0 + (lane & 31);
#pragma unroll
    for (int i = 0; i < 32; ++i) { const int kk = 2 * i + (lane >> 5); scr[kk * 33 + (lane & 31)] = (nn < t.Nsrc) ? t.W[(size_t)(k0 + kk) * t.Nsrc + nn] : 0.f; }
    LDS_WAIT(); asm volatile("" ::: "memory");
    const int c = lane & 7;
#pragma unroll
    for (int j = 0; j < 4; ++j) { const int n = (lane >> 3) + 8 * j; const LAS float* s = scr + (8 * c) * 33 + n;
        u32x4 o; o.x = cvtpk(s[0 * 33], s[1 * 33]); o.y = cvtpk(s[2 * 33], s[3 * 33]); o.z = cvtpk(s[4 * 33], s[5 * 33]); o.w = cvtpk(s[6 * 33], s[7 * 33]);
        const int row = rowmap(t.mode, t.arg, n0 + n);
        *(u32x4*)(t.WT + (size_t)row * t.K + k0 + 8 * c) = o; }
    LDS_WAIT(); asm volatile("" ::: "memory");
}
DI void prologue_phase(const Params& P, LAS unsigned char* lds, int gw, int NGW, int wave, int lane) {
    LAS float* scr = (LAS float*)(lds + wave * 16384);
    for (int gi = gw; gi < 2 * 8960; gi += NGW) {
        const int l = gi >= 8960 ? 1 : 0; int r = gi - l * 8960, j, it;
        if (r < 1536) { j = 0; it = r; }
        else if ((r -= 1536) < 2048) { j = 1 + (r >> 9); it = r & 511; }
        else if ((r -= 2048) < 512) { j = 5 + (r >> 7); it = r & 127; }
        else if ((r -= 512) < 512) { j = 9; it = r; }
        else if ((r -= 512) < 2816) { j = 10 + (r >= 1408 ? 1 : 0); it = r >= 1408 ? r - 1408 : r; }
        else if ((r -= 2816) < 1408) { j = 12; it = r; }
        else { r -= 1408; j = 13 + (r >> 6); it = r & 63; }
        const TJob t = get_job(P, l, j);
        transpose_item(t, scr, it, lane);
    }
}

DI void rms_phase(const float* x, const float* g, bf16_t* out, int gw, int NGW, int lane) {
    f32x4 gv[4];
#pragma unroll
    for (int j = 0; j < 4; ++j) gv[j] = ((const f32x4*)g)[lane + 64 * j];
    for (int m = gw; m < TOK; m += 2 * NGW) {
        const int m2 = m + NGW; const bool has2 = m2 < TOK;
        const f32x4* xa = (const f32x4*)(x + (size_t)m * DM) + lane; const f32x4* xb = (const f32x4*)(x + (size_t)(has2 ? m2 : m) * DM) + lane;
        f32x4 va[4], vb[4]; float sa = 0.f, sb = 0.f;
#pragma unroll
        for (int j = 0; j < 4; ++j) { va[j] = xa[64 * j]; vb[j] = xb[64 * j]; }
#pragma unroll
        for (int j = 0; j < 4; ++j) { sa += (va[j].x * va[j].x + va[j].y * va[j].y) + (va[j].z * va[j].z + va[j].w * va[j].w);
                                      sb += (vb[j].x * vb[j].x + vb[j].y * vb[j].y) + (vb[j].z * vb[j].z + vb[j].w * vb[j].w); }
        const float ra = 1.0f / sqrtf(wave_sum(sa, lane) * (1.0f / DM) + RMS_EPS), rb = 1.0f / sqrtf(wave_sum(sb, lane) * (1.0f / DM) + RMS_EPS);
        unsigned long long* oa = (unsigned long long*)(out + (size_t)m * DM) + lane;
#pragma unroll
        for (int j = 0; j < 4; ++j) { const f32x4 y = va[j] * ra * gv[j]; oa[64 * j] = (unsigned long long)cvtpk(y.x, y.y) | ((unsigned long long)cvtpk(y.z, y.w) << 32); }
        if (has2) { unsigned long long* ob = (unsigned long long*)(out + (size_t)m2 * DM) + lane;
#pragma unroll
            for (int j = 0; j < 4; ++j) { const f32x4 y = vb[j] * rb * gv[j]; ob[64 * j] = (unsigned long long)cvtpk(y.x, y.y) | ((unsigned long long)cvtpk(y.z, y.w) << 32); } }
    }
}

DI void rope_cs(float pos, float inv, float& c, float& s) {
    const float ang = pos * inv; double rev = (double)ang * 0.15915494309189535; rev -= __builtin_rint(rev);
    const float r = (float)rev; s = __builtin_amdgcn_sinf(r); c = __builtin_amdgcn_cosf(r);
}
constexpr float LOG2_THETA = 18.931568569324174f;
DI void unpack8(const u32x4 w, float (&v)[8]) { v[0] = bflo(w.x); v[1] = bfhi(w.x); v[2] = bflo(w.y); v[3] = bfhi(w.y); v[4] = bflo(w.z); v[5] = bfhi(w.z); v[6] = bflo(w.w); v[7] = bfhi(w.w); }

constexpr float LOG2E_ = 1.4426950408889634f;
DI void prep_norm_item(const Params& P, int l, int it, int lane) {
    bf16_t* hb = (bf16_t*)(P.ws + WS_H);
    const int blk = it / 10, sp10 = it % 10, sp = sp10 < 4 ? 4 + sp10 : (sp10 < 8 ? 8 + sp10 : 12 + sp10), sub = lane & 7, tl = lane >> 3;
    int col; const float* g; bool diff = false, km = false; float qs = 1.0f;
    if (sp < 4) { col = C_DFQ + 64 * sp; g = P.in[3] + l * 32; diff = true; qs = 0.17677669529663687f * LOG2E_; }
    else if (sp < 8) { col = C_DFK + 64 * (sp - 4); g = P.in[4] + l * 32; diff = true; }
    else if (sp < 12) { col = C_MBQ + 64 * (sp - 8); g = P.in[7] + l * 64; qs = 0.125f * LOG2E_; }
    else if (sp < 16) { col = C_MBK + 64 * (sp - 12); g = P.in[8] + l * 64; km = true; }
    else if (sp < 20) { col = C_NSQ + 64 * (sp - 16); g = P.in[9] + l * 64; qs = 0.125f * LOG2E_; }
    else if (sp == 20) { col = C_KS; g = P.in[10] + (l * 3 + 1) * 64; }
    else { col = C_KW; g = P.in[10] + (l * 3 + 2) * 64; }
    float gv[8], inv[8], kacc[8];
#pragma unroll
    for (int e = 0; e < 8; ++e) { gv[e] = (diff ? g[8 * (sub & 3) + e] : g[8 * sub + e]); kacc[e] = 0.f;
        inv[e] = diff ? exp2f(-(float)(e & 3) * 0.25f * LOG2_THETA) : exp2f(-(float)e * 0.125f * LOG2_THETA); }
    u32x4* p0 = (u32x4*)(hb + (size_t)(blk * 64 + tl) * NIN + col + 8 * sub);
    u32x4 raw[8];
#pragma unroll
    for (int i = 0; i < 8; ++i) raw[i] = p0[(size_t)i * 8 * NIN / 8];
#pragma unroll
    for (int i = 0; i < 8; ++i) {
        const int tok = blk * 64 + 8 * i + tl; const float pos = (float)(tok & (SEQ - 1));
        float v[8]; unpack8(raw[i], v);
        float ss = 0.f;
#pragma unroll
        for (int e = 0; e < 8; ++e) ss += v[e] * v[e];
        ss += shx(ss, 1, lane); ss += shx(ss, 2, lane);
        if (!diff) ss += shx(ss, 4, lane);
        const float rstd = 1.0f / sqrtf(ss * (diff ? (1.0f / 32.0f) : (1.0f / 64.0f)) + RMS_EPS);
#pragma unroll
        for (int e = 0; e < 8; ++e) v[e] = v[e] * rstd * gv[e];
        if (diff) {
            if ((sub & 3) == 0) {
#pragma unroll
                for (int e = 0; e < 4; ++e) { float c, s; rope_cs(pos, inv[e], c, s); const float a = v[e], b = v[e + 4]; v[e] = a * c - b * s; v[e + 4] = b * c + a * s; }
            }
        } else {
            float pr[8];
#pragma unroll
            for (int e = 0; e < 8; ++e) pr[e] = shx(v[e], 1, lane);
            if (sub < 2) {
#pragma unroll
                for (int e = 0; e < 8; ++e) { float c, s; rope_cs(pos, inv[e], c, s); v[e] = (sub == 0) ? (v[e] * c - pr[e] * s) : (v[e] * c + pr[e] * s); }
            }
        }
#pragma unroll
        for (int e = 0; e < 8; ++e) kacc[e] += v[e];
        u32x4 w; w.x = cvtpk(v[0] * qs, v[1] * qs); w.y = cvtpk(v[2] * qs, v[3] * qs); w.z = cvtpk(v[4] * qs, v[5] * qs); w.w = cvtpk(v[6] * qs, v[7] * qs);
        p0[(size_t)i * 8 * NIN / 8] = w;
    }
    if (km) {
#pragma unroll
        for (int e = 0; e < 8; ++e) { float a = kacc[e]; a += shx(a, 8, lane); a += shx(a, 16, lane); a += shx32(a, lane); kacc[e] = a; }
        if (tl == 0) { float* kmp = (float*)(P.ws + WS_KMEAN) + ((((size_t)((blk >> 6) * 4 + (sp - 12)) * 16 + ((blk >> 2) & 15)) * 4 + (blk & 3)) * 64) + 8 * sub;
            *(f32x4*)kmp = (f32x4){kacc[0], kacc[1], kacc[2], kacc[3]}; *(f32x4*)(kmp + 4) = (f32x4){kacc[4], kacc[5], kacc[6], kacc[7]}; }
    }
}
#define MFMA32(a, b, c) __builtin_amdgcn_mfma_f32_32x32x16_bf16((a), (b), (c), 0, 0, 0)
DI void prep_compress_item(const Params& P, int l, int it, LAS unsigned char* lds, int wave, int lane) {
    const bf16_t* hb = (const bf16_t*)(P.ws + WS_H);
    const int kv = it & 1, nt = (it >> 1) & 7, b = it >> 4, r = lane & 31, h = lane >> 5;
    const bf16_t* cw = (const bf16_t*)(P.ws + WS_CWT) + (size_t)(l * 2 + kv) * 64 * 2048;
    const float* pe = P.in[11] + (size_t)(l * 2 + kv) * 32 * 64;
    const int col = kv ? C_VC : C_KC, n = 32 * nt + r;
    f32x16 acc[2];
#pragma unroll
    for (int i = 0; i < 16; ++i) { acc[0][i] = 0.f; acc[1][i] = 0.f; }
#pragma unroll
    for (int jj = 0; jj < 4; ++jj) {
        const int j = 4 * wave + jj;
        int tok = 16 * n + j; tok = tok > SEQ - 1 ? SEQ - 1 : tok;
        const bf16_t* xp = hb + (size_t)(b * SEQ + tok) * NIN + col + 8 * h;
#pragma unroll
        for (int ds = 0; ds < 4; ++ds) {
            float v[8]; unpack8(*(const u32x4*)(xp + 16 * ds), v);
            const f32x4 p0 = *(const f32x4*)(pe + j * 64 + 16 * ds + 8 * h), p1 = *(const f32x4*)(pe + j * 64 + 16 * ds + 8 * h + 4);
            u32x4 w; w.x = cvtpk(v[0] + p0[0], v[1] + p0[1]); w.y = cvtpk(v[2] + p0[2], v[3] + p0[3]); w.z = cvtpk(v[4] + p1[0], v[5] + p1[1]); w.w = cvtpk(v[6] + p1[2], v[7] + p1[3]);
            const bf16x8 bfrag = __builtin_bit_cast(bf16x8, w);
            const int k0 = j * 64 + 16 * ds + 8 * h;
            const bf16x8 a0 = *(const bf16x8*)(cw + (size_t)r * 2048 + k0), a1 = *(const bf16x8*)(cw + (size_t)(32 + r) * 2048 + k0);
            acc[0] = MFMA32(a0, bfrag, acc[0]); acc[1] = MFMA32(a1, bfrag, acc[1]);
        }
    }
    LAS float* part = (LAS float*)lds;
#pragma unroll
    for (int et = 0; et < 2; ++et)
#pragma unroll
        for (int i = 0; i < 16; ++i) part[(wave * 32 + et * 16 + i) * 64 + lane] = acc[et][i];
    __syncthreads();
    if (wave == 0) {
#pragma unroll
        for (int et = 0; et < 2; ++et)
#pragma unroll
            for (int i = 0; i < 16; ++i) { float a = acc[et][i];
#pragma unroll
                for (int w = 1; w < 8; ++w) a += part[(w * 32 + et * 16 + i) * 64 + lane];
                acc[et][i] = a; }
        if (kv == 0) {
            const float* g = P.in[10] + (size_t)(l * 3 + 0) * 64;
            float ss = 0.f;
#pragma unroll
            for (int i = 0; i < 16; ++i) ss += acc[0][i] * acc[0][i] + acc[1][i] * acc[1][i];
            ss += shx32(ss, lane);
            const float rstd = 1.0f / sqrtf(ss * (1.0f / 64.0f) + RMS_EPS);
#pragma unroll
            for (int et = 0; et < 2; ++et)
#pragma unroll
                for (int i = 0; i < 16; ++i) { const int e = 32 * et + (i & 3) + 8 * (i >> 2) + 4 * h; acc[et][i] = acc[et][i] * rstd * g[e]; }
            const float pos = (float)(16 * n + 31);
#pragma unroll
            for (int i = 0; i < 4; ++i) { const int e = 4 * h + i; float c, s; rope_cs(pos, exp2f(-(float)e * 0.125f * LOG2_THETA), c, s);
                const float a = acc[0][i], bq = acc[0][i + 4]; acc[0][i] = a * c - bq * s; acc[0][i + 4] = bq * c + a * s; }
        }
        bf16_t* dst = (bf16_t*)(P.ws + (kv ? WS_VC : WS_KC)) + (size_t)(b * 256 + n) * 64;
#pragma unroll
        for (int et = 0; et < 2; ++et)
#pragma unroll
            for (int gq = 0; gq < 4; ++gq) { u32x2 w; w.x = cvtpk(acc[et][4 * gq], acc[et][4 * gq + 1]); w.y = cvtpk(acc[et][4 * gq + 2], acc[et][4 * gq + 3]);
                *(u32x2*)(dst + 32 * et + 8 * gq + 4 * h) = w; }
    }
    __syncthreads();
}
DI void prep_phase(const Params& P, int l, LAS unsigned char* lds, int G, int bx, int gw, int NGW, int wave, int lane) {
    for (int it = bx; it < 128; it += G) prep_compress_item(P, l, it, lds, wave, lane);
    if (G == 256) {
        prep_norm_item(P, l, gw, lane); prep_norm_item(P, l, gw + NGW, lane);
        if (bx >= 128) prep_norm_item(P, l, 4096 + (bx - 128) * 8 + wave, lane);
    } else {
        for (int it = gw; it < 512 * 10; it += NGW) prep_norm_item(P, l, it, lane);
    }
}
typedef short v4i16_t __attribute__((ext_vector_type(4)));
constexpr int KP = 144;
constexpr int TILE_B = 64 * KP;
constexpr float LOG2E = 1.4426950408889634f;
enum { MODE_DIFF = 0, MODE_MOBA = 1, MODE_NSEL = 2, MODE_NWIN = 3 };

DI s16x4 vtr(LAS const char* p) { return __builtin_bit_cast(s16x4, __builtin_amdgcn_ds_read_tr16_b64_v4i16((LAS v4i16_t*)p)); }
DI float ex2(float x) { return __builtin_amdgcn_exp2f(x); }

template <int KS0, int KS1> DI f32x16 qk_rows(LAS const char* Kl, int row0, const bf16x8 (&qf)[4], int r, int h) {
    f32x16 s;
#pragma unroll
    for (int i = 0; i < 16; ++i) s[i] = 0.f;
    LAS const char* p = Kl + (row0 + r) * KP + 16 * h;
    bf16x8 kf[4];
#pragma unroll
    for (int ks = KS0; ks < KS1; ++ks) kf[ks] = *(LAS const bf16x8*)(p + 32 * ks);
    __builtin_amdgcn_s_setprio(1);
#pragma unroll
    for (int ks = KS0; ks < KS1; ++ks) s = MFMA32(kf[ks], qf[ks], s);
    __builtin_amdgcn_s_setprio(0);
    return s;
}
DI void pv_rows(f32x16 (&o)[2], LAS const char* Vl, int row0, const bf16x8 (&pf)[2], int lane) {
    const int h = lane >> 5, i = lane & 15, grp = (lane >> 4) & 1;
    LAS const char* base = Vl + (row0 + 4 * h + (i >> 2)) * KP + grp * 32 + (i & 3) * 8;
    bf16x8 vf[2][2];
#pragma unroll
    for (int dt = 0; dt < 2; ++dt)
#pragma unroll
        for (int s2 = 0; s2 < 2; ++s2) {
            const s16x4 lo = vtr(base + (16 * s2) * KP + dt * 64), hi = vtr(base + (16 * s2 + 8) * KP + dt * 64);
            vf[dt][s2] = (bf16x8){lo[0], lo[1], lo[2], lo[3], hi[0], hi[1], hi[2], hi[3]};
        }
    __builtin_amdgcn_s_setprio(1);
#pragma unroll
    for (int s2 = 0; s2 < 2; ++s2)
#pragma unroll
        for (int dt = 0; dt < 2; ++dt) o[dt] = MFMA32(vf[dt][s2], pf[s2], o[dt]);
    __builtin_amdgcn_s_setprio(0);
}
DI void pack_p(const float (&p)[16], bf16x8 (&pf)[2]) {
#pragma unroll
    for (int s2 = 0; s2 < 2; ++s2) { u32x4 w; w.x = cvtpk(p[8 * s2], p[8 * s2 + 1]); w.y = cvtpk(p[8 * s2 + 2], p[8 * s2 + 3]); w.z = cvtpk(p[8 * s2 + 4], p[8 * s2 + 5]); w.w = cvtpk(p[8 * s2 + 6], p[8 * s2 + 7]);
        pf[s2] = __builtin_bit_cast(bf16x8, w); }
}
template <int MM> DI void smax_step(const f32x16& s, unsigned vm, float& m, float& l, f32x16 (&o)[2], bf16x8 (&pf)[2], int lane) {
    float t[16], mx = -1e30f;
#pragma unroll
    for (int i = 0; i < 16; ++i) { t[i] = (MM == 0) ? s[i] : (MM == 1 ? (vm ? s[i] : -1e30f) : (((vm >> i) & 1u) ? s[i] : -1e30f)); mx = fmaxf(mx, t[i]); }
    mx = fmaxf(mx, shx32(mx, lane));
    const float mn = (mx > m + 8.0f) ? mx : m;
    const float mref = fmaxf(mn, -1e29f);
    float p[16], rs = 0.f;
#pragma unroll
    for (int i = 0; i < 16; ++i) { p[i] = ex2(t[i] - mref); rs += p[i]; }
    rs += shx32(rs, lane);
    if (__builtin_amdgcn_ballot_w64(mn != m) != 0ull) {
        const float alpha = ex2(m - mn);
        l *= alpha;
#pragma unroll
        for (int i = 0; i < 16; ++i) { o[0][i] *= alpha; o[1][i] *= alpha; }
        m = mn;
    }
    l += rs;
    pack_p(p, pf);
}
template <int MM> DI void smax_step64(const f32x16& sa, const f32x16& sb, unsigned vm, float& m, float& l, f32x16 (&o)[2], bf16x8 (&pf)[4], int lane) {
    float mx = -1e30f;
#pragma unroll
    for (int i = 0; i < 16; ++i) mx = fmaxf(mx, fmaxf(sa[i], sb[i]));
    if (MM == 1) mx = vm ? mx : -1e30f;
    mx = fmaxf(mx, shx32(mx, lane));
    const float mn = (mx > m + 8.0f) ? mx : m;
    float mref = fmaxf(mn, -1e29f);
    if (MM == 1) mref = vm ? mref : 3e38f;
    float rs = 0.f;
    {   float pa[16]; bf16x8 t2[2];
#pragma unroll
        for (int i = 0; i < 16; ++i) { pa[i] = ex2(sa[i] - mref); rs += pa[i]; }
        pack_p(pa, t2); pf[0] = t2[0]; pf[1] = t2[1]; }
    {   float pb[16]; bf16x8 t2[2];
#pragma unroll
        for (int i = 0; i < 16; ++i) { pb[i] = ex2(sb[i] - mref); rs += pb[i]; }
        pack_p(pb, t2); pf[2] = t2[0]; pf[3] = t2[1]; }
    rs += shx32(rs, lane);
    if (__builtin_amdgcn_ballot_w64(mn != m) != 0ull) {
        const float alpha = ex2(m - mn);
        l *= alpha;
#pragma unroll
        for (int i = 0; i < 16; ++i) { o[0][i] *= alpha; o[1][i] *= alpha; }
        m = mn;
    }
    l += rs;
}
DI void pv_rows64(f32x16 (&o)[2], LAS const char* Vl, const bf16x8 (&pf)[4], int lane) {
    const int h = lane >> 5, i = lane & 15, grp = (lane >> 4) & 1;
    LAS const char* base = Vl + (4 * h + (i >> 2)) * KP + grp * 32 + (i & 3) * 8;
#pragma unroll
    for (int s4 = 0; s4 < 4; ++s4)
#pragma unroll
        for (int dt = 0; dt < 2; ++dt) {
            const s16x4 lo = vtr(base + (16 * s4) * KP + dt * 64), hi = vtr(base + (16 * s4 + 8) * KP + dt * 64);
            const bf16x8 vf = {lo[0], lo[1], lo[2], lo[3], hi[0], hi[1], hi[2], hi[3]};
            o[dt] = MFMA32(vf, pf[s4], o[dt]);
        }
}
template <int MM> DI void smax_step_nb(const f32x16& s, unsigned vm, float& m, float& l, f32x16 (&o)[2], bf16x8 (&pf)[2], int lane) {
    float mx = -1e30f;
#pragma unroll
    for (int i = 0; i < 16; ++i) mx = fmaxf(mx, s[i]);
    if (MM == 1) mx = vm ? mx : -1e30f;
    mx = fmaxf(mx, shx32(mx, lane));
    const float mn = (mx > m + 8.0f) ? mx : m;
    float mref = fmaxf(mn, -1e29f);
    if (MM == 1) mref = vm ? mref : 3e38f;
    const float alpha = ex2(m - mn);
    float p[16], rs = 0.f;
#pragma unroll
    for (int i = 0; i < 16; ++i) { p[i] = ex2(s[i] - mref); rs += p[i]; }
    rs += shx32(rs, lane);
    l = l * alpha + rs;
    if (__builtin_amdgcn_ballot_w64(mn != m) != 0ull) {
#pragma unroll
        for (int i = 0; i < 16; ++i) { o[0][i] *= alpha; o[1][i] *= alpha; }
    }
    m = mn;
    pack_p(p, pf);
}
template <int MM> DI void tile64_pipe(LAS const char* Kl, LAS const char* Vl, const bf16x8 (&qf)[4], unsigned vm, float& m, float& l, f32x16 (&o)[2], int r, int h, int lane) {
    const f32x16 sa = qk_rows<0, 4>(Kl, 0, qf, r, h), sb = qk_rows<0, 4>(Kl, 32, qf, r, h);
    bf16x8 pfa[2], pfb[2];
    smax_step_nb<MM>(sa, vm, m, l, o, pfa, lane);
    pv_rows(o, Vl, 0, pfa, lane);
    smax_step_nb<MM>(sb, vm, m, l, o, pfb, lane);
    pv_rows(o, Vl, 32, pfb, lane);
}
template <int MM> DI void tile128_pipe(LAS const char* K0, LAS const char* V0, LAS const char* K1, LAS const char* V1, const bf16x8 (&qf)[4], unsigned vm0, unsigned vm1,
                                       float& m, float& l, f32x16 (&o)[2], int r, int h, int lane) {
    f32x16 sa = qk_rows<0, 4>(K0, 0, qf, r, h), sb = qk_rows<0, 4>(K0, 32, qf, r, h);
    bf16x8 pfa[2], pfb[2];
    smax_step_nb<MM>(sa, vm0, m, l, o, pfa, lane);
    sa = qk_rows<0, 4>(K1, 0, qf, r, h);
    pv_rows(o, V0, 0, pfa, lane);
    smax_step_nb<MM>(sb, vm0, m, l, o, pfb, lane);
    sb = qk_rows<0, 4>(K1, 32, qf, r, h);
    pv_rows(o, V0, 32, pfb, lane);
    smax_step_nb<MM>(sa, vm1, m, l, o, pfa, lane);
    pv_rows(o, V1, 0, pfa, lane);
    smax_step_nb<MM>(sb, vm1, m, l, o, pfb, lane);
    pv_rows(o, V1, 32, pfb, lane);
}
struct Stage { u32x4 k, v; };
DI void stage_load(Stage& st, const bf16_t* Kg, const bf16_t* Vg, int pitch, int key0, int tid) {
    const int key = tid >> 3, c = tid & 7;
    st.k = *(const u32x4*)(Kg + (size_t)(key0 + key) * pitch + 8 * c); st.v = *(const u32x4*)(Vg + (size_t)(key0 + key) * pitch + 8 * c);
}
DI void stage_store(const Stage& st, LAS char* Kl, LAS char* Vl, int tid) {
    const int key = tid >> 3, c = tid & 7;
    *(LAS u32x4*)(Kl + key * KP + 16 * c) = st.k; *(LAS u32x4*)(Vl + key * KP + 16 * c) = st.v;
}
DI void zero_o(f32x16 (&o)[2]) {
#pragma unroll
    for (int i = 0; i < 16; ++i) { o[0][i] = 0.f; o[1][i] = 0.f; }
}
DI void load_q(bf16x8 (&qf)[4], const bf16_t* qrow, int h) {
#pragma unroll
    for (int ks = 0; ks < 4; ++ks) qf[ks] = *(const bf16x8*)(qrow + 16 * ks + 8 * h);
}
DI void store_o(bf16_t* dst, const f32x16 (&o)[2], int h) {
#pragma unroll
    for (int dt = 0; dt < 2; ++dt)
#pragma unroll
        for (int g = 0; g < 4; ++g) { u32x2 w; w.x = cvtpk(o[dt][4 * g], o[dt][4 * g + 1]); w.y = cvtpk(o[dt][4 * g + 2], o[dt][4 * g + 3]);
            *(u32x2*)(dst + 32 * dt + 8 * g + 4 * h) = w; }
}

template <bool DIFFQ> DI void norm_rope_q(bf16x8 (&qf)[4], const float* g, float qs, int qpos, int h, int lane) {
    float qv[4][8];
#pragma unroll
    for (int ks = 0; ks < 4; ++ks) unpack8(__builtin_bit_cast(u32x4, qf[ks]), qv[ks]);
    float ssa = 0.f, ssb = 0.f;
#pragma unroll
    for (int j = 0; j < 8; ++j) { ssa += qv[0][j] * qv[0][j] + qv[1][j] * qv[1][j]; ssb += qv[2][j] * qv[2][j] + qv[3][j] * qv[3][j]; }
    ssa += shx32(ssa, lane); ssb += shx32(ssb, lane);
    float ra, rb;
    if (DIFFQ) { ra = 1.0f / sqrtf(ssa * (1.0f / 32.0f) + RMS_EPS); rb = 1.0f / sqrtf(ssb * (1.0f / 32.0f) + RMS_EPS); }
    else { ra = rb = 1.0f / sqrtf((ssa + ssb) * (1.0f / 64.0f) + RMS_EPS); }
#pragma unroll
    for (int ks = 0; ks < 4; ++ks)
#pragma unroll
        for (int j = 0; j < 8; ++j) { const int d = 16 * ks + 8 * h + j; qv[ks][j] = qv[ks][j] * (ks < 2 ? ra : rb) * g[DIFFQ ? (d & 31) : d]; }
    const float pos = (float)qpos;
    if (DIFFQ) {
        if (h == 0) {
#pragma unroll
            for (int mp = 0; mp < 2; ++mp)
#pragma unroll
                for (int e = 0; e < 4; ++e) { float c, sn; rope_cs(pos, exp2f(-(float)e * 0.25f * LOG2_THETA), c, sn);
                    const float a = qv[2 * mp][e], bq = qv[2 * mp][e + 4]; qv[2 * mp][e] = a * c - bq * sn; qv[2 * mp][e + 4] = bq * c + a * sn; }
        }
    } else {
        float pr[8];
#pragma unroll
        for (int j = 0; j < 8; ++j) pr[j] = shx32(qv[0][j], lane);
#pragma unroll
        for (int e = 0; e < 8; ++e) { float c, sn; rope_cs(pos, exp2f(-(float)e * 0.125f * LOG2_THETA), c, sn);
            qv[0][e] = (h == 0) ? (qv[0][e] * c - pr[e] * sn) : (qv[0][e] * c + pr[e] * sn); }
    }
#pragma unroll
    for (int ks = 0; ks < 4; ++ks) { u32x4 w; w.x = cvtpk(qv[ks][0] * qs, qv[ks][1] * qs); w.y = cvtpk(qv[ks][2] * qs, qv[ks][3] * qs); w.z = cvtpk(qv[ks][4] * qs, qv[ks][5] * qs); w.w = cvtpk(qv[ks][6] * qs, qv[ks][7] * qs);
        qf[ks] = __builtin_bit_cast(bf16x8, w); }
}
struct Stage2 { u32x4 k0, v0, k1, v1; };
DI void flash_prefetch(Stage2& st, const bf16_t* Kg, const bf16_t* Vg, int pitch, int kt_lo, int kt_hi, int tid) {
    const int skey = tid >> 3, sc = tid & 7, t1 = (kt_lo + 1 > kt_hi) ? kt_hi : kt_lo + 1;
    const size_t a0 = (size_t)(64 * kt_lo + skey) * pitch + 8 * sc, a1 = (size_t)(64 * t1 + skey) * pitch + 8 * sc;
    st.k0 = *(const u32x4*)(Kg + a0); st.v0 = *(const u32x4*)(Vg + a0); st.k1 = *(const u32x4*)(Kg + a1); st.v1 = *(const u32x4*)(Vg + a1);
}
template <int MODE, bool PRE = false>
DI void flash_tiles(LAS char* lds, const bf16_t* Kg, const bf16_t* Vg, int pitch, int kt_lo, int kt_hi,
                    const bf16x8 (&qf)[4], int qpos, int q0w, unsigned long long sel, float c,
                    float& m1, float& l1, f32x16 (&o1)[2], float& m2, float& l2, f32x16 (&o2)[2], int tid, int lane, Stage2& st) {
    const int n = kt_hi - kt_lo + 1;
    if (n <= 0) return;
    const int r = lane & 31, h = lane >> 5, nst = (n + 1) >> 1;
    const int skey = tid >> 3, sc = tid & 7;
#define ST2_LOAD(T0) do { const int t0_ = (T0), t1_ = (t0_ + 1 > kt_hi) ? kt_hi : t0_ + 1; \
        const size_t a0_ = (size_t)(64 * t0_ + skey) * pitch + 8 * sc, a1_ = (size_t)(64 * t1_ + skey) * pitch + 8 * sc; \
        st.k0 = *(const u32x4*)(Kg + a0_); st.v0 = *(const u32x4*)(Vg + a0_); st.k1 = *(const u32x4*)(Kg + a1_); st.v1 = *(const u32x4*)(Vg + a1_); } while (0)
#define ST2_STORE(BUF) do { LAS char* b_ = lds + (BUF) * 4 * TILE_B + skey * KP + 16 * sc; \
        *(LAS u32x4*)(b_) = st.k0; *(LAS u32x4*)(b_ + TILE_B) = st.v0; *(LAS u32x4*)(b_ + 2 * TILE_B) = st.k1; *(LAS u32x4*)(b_ + 3 * TILE_B) = st.v1; } while (0)
    if (!PRE) ST2_LOAD(kt_lo);
    ST2_STORE(0);
    __syncthreads();
    for (int sti = 0; sti < nst; ++sti) {
        if (sti + 1 < nst) ST2_LOAD(kt_lo + 2 * (sti + 1));
        if (MODE != MODE_DIFF) {
            const int kt0 = kt_lo + 2 * sti;
            bool both = (kt0 + 1 <= kt_hi) && (64 * kt0 + 127 <= q0w);
            if (MODE == MODE_NWIN) both = both && (64 * kt0 > q0w + 31 - 512);
            if (both) {
                bool ls0 = true, ls1 = true;
                if (MODE == MODE_MOBA) { ls0 = ((sel >> (kt0 >> 2)) & 1ull) != 0ull; ls1 = ((sel >> ((kt0 + 1) >> 2)) & 1ull) != 0ull; }
                if (MODE == MODE_NSEL) { ls0 = ((sel >> kt0) & 1ull) != 0ull; ls1 = ((sel >> (kt0 + 1)) & 1ull) != 0ull; }
                const unsigned long long b0 = __builtin_amdgcn_ballot_w64(ls0), b1 = __builtin_amdgcn_ballot_w64(ls1);
                if (b0 != 0ull && b1 != 0ull) {
                    LAS char* K0 = lds + (sti & 1) * 4 * TILE_B;
                    if ((b0 & b1) == ~0ull) tile128_pipe<0>(K0, K0 + TILE_B, K0 + 2 * TILE_B, K0 + 3 * TILE_B, qf, 1u, 1u, m1, l1, o1, r, h, lane);
                    else tile128_pipe<1>(K0, K0 + TILE_B, K0 + 2 * TILE_B, K0 + 3 * TILE_B, qf, ls0 ? 1u : 0u, ls1 ? 1u : 0u, m1, l1, o1, r, h, lane);
                    goto step_done;
                }
            }
        }
#pragma unroll 1
        for (int half = 0; half < 2; ++half) {
        const int kt = kt_lo + 2 * sti + half;
        if (kt > kt_hi) break;
        LAS char* Kl = lds + (sti & 1) * 4 * TILE_B + half * 2 * TILE_B; LAS char* Vl = Kl + TILE_B;
        bool full2 = (64 * kt + 63 <= q0w);
        if (MODE == MODE_NWIN) full2 = full2 && (64 * kt > q0w + 31 - 512);
        if (full2 && (MODE != MODE_DIFF || DIFF_MERGED)) {
            bool lsel = true;
            if (MODE == MODE_MOBA) lsel = ((sel >> (kt >> 2)) & 1ull) != 0ull;
            if (MODE == MODE_NSEL) lsel = ((sel >> kt) & 1ull) != 0ull;
            const unsigned long long selb = __builtin_amdgcn_ballot_w64(lsel);
            if (selb != 0ull) {
                const unsigned vm = lsel ? 1u : 0u; bf16x8 pf[4];
                if (MODE == MODE_DIFF) {
                    { const f32x16 sa = qk_rows<0, 2>(Kl, 0, qf, r, h), sb = qk_rows<0, 2>(Kl, 32, qf, r, h);
                      smax_step64<0>(sa, sb, vm, m1, l1, o1, pf, lane); __builtin_amdgcn_sched_barrier(0); pv_rows64(o1, Vl, pf, lane); }
                    __builtin_amdgcn_sched_barrier(0);
                    { const f32x16 sa = qk_rows<2, 4>(Kl, 0, qf, r, h), sb = qk_rows<2, 4>(Kl, 32, qf, r, h);
                      smax_step64<0>(sa, sb, vm, m2, l2, o2, pf, lane); __builtin_amdgcn_sched_barrier(0); pv_rows64(o2, Vl, pf, lane); }
                } else {
#if PIPE64
                    if (selb == ~0ull) tile64_pipe<0>(Kl, Vl, qf, vm, m1, l1, o1, r, h, lane); else tile64_pipe<1>(Kl, Vl, qf, vm, m1, l1, o1, r, h, lane);
#else
                    const f32x16 sa = qk_rows<0, 4>(Kl, 0, qf, r, h), sb = qk_rows<0, 4>(Kl, 32, qf, r, h);
                    if (selb == ~0ull) smax_step64<0>(sa, sb, vm, m1, l1, o1, pf, lane); else smax_step64<1>(sa, sb, vm, m1, l1, o1, pf, lane);
                    pv_rows64(o1, Vl, pf, lane);
#endif
                }
            }
        } else
#pragma unroll
        for (int sub = 0; sub < 2; ++sub) {
            const int kbase = 64 * kt + 32 * sub;
            if (kbase > q0w + 31) continue;
            if (MODE == MODE_NWIN && kbase + 31 <= q0w - 512) continue;
            bool full = (kbase + 31 <= q0w);
            if (MODE == MODE_NWIN) full = full && (kbase > q0w + 31 - 512);
            bool lsel = true;
            if (MODE == MODE_MOBA) lsel = ((sel >> (kbase >> 8)) & 1ull) != 0ull;
            if (MODE == MODE_NSEL) lsel = ((sel >> kt) & 1ull) != 0ull;
            const unsigned long long selb = __builtin_amdgcn_ballot_w64(lsel);
            if (selb == 0ull) continue;
            int mm; unsigned vm;
            if (full) { mm = (selb == ~0ull) ? 0 : 1; vm = lsel ? 1u : 0u; }
            else { mm = 2; vm = 0;
#pragma unroll
                for (int i = 0; i < 16; ++i) { const int kidx = kbase + (i & 3) + 8 * (i >> 2) + 4 * h; bool ok = kidx <= qpos; if (MODE == MODE_NWIN) ok = ok && (kidx > qpos - 512); vm |= ok ? (1u << i) : 0u; }
                if (!lsel) vm = 0;
                if (__builtin_amdgcn_ballot_w64(vm != 0) == 0ull) continue; }
            bf16x8 pf[2];
            if (MODE == MODE_DIFF) {
                const f32x16 s1 = qk_rows<0, 2>(Kl, 32 * sub, qf, r, h), s2 = qk_rows<2, 4>(Kl, 32 * sub, qf, r, h);
                bf16x8 pf2[2];
                if (mm == 0) { smax_step<0>(s1, vm, m1, l1, o1, pf, lane); smax_step<0>(s2, vm, m2, l2, o2, pf2, lane); }
                else { smax_step<2>(s1, vm, m1, l1, o1, pf, lane); smax_step<2>(s2, vm, m2, l2, o2, pf2, lane); }
                pv_rows(o1, Vl, 32 * sub, pf, lane);
                pv_rows(o2, Vl, 32 * sub, pf2, lane);
            } else {
                const f32x16 s = qk_rows<0, 4>(Kl, 32 * sub, qf, r, h);
                if (mm == 0) smax_step<0>(s, vm, m1, l1, o1, pf, lane); else if (mm == 1) smax_step<1>(s, vm, m1, l1, o1, pf, lane); else smax_step<2>(s, vm, m1, l1, o1, pf, lane);
                pv_rows(o1, Vl, 32 * sub, pf, lane);
            }
        }
        }
        step_done:
        if (sti + 1 < nst) ST2_STORE((sti + 1) & 1);
        __syncthreads();
    }
#undef ST2_LOAD
#undef ST2_STORE
}

DI void sb_unit(const Params& P, LAS char* lds, int b, int hd, int qb, int wave, int lane) {
    const bf16_t* hb = (const bf16_t*)(P.ws + WS_H);
    const int r = lane & 31, h = lane >> 5, q0w = 256 * qb + 32 * wave, qpos = q0w + r;
    bf16x8 qf[4]; load_q(qf, hb + (size_t)(b * SEQ + qpos) * NIN + C_SBQ + 64 * hd, h);
    const bf16_t* Kg = hb + (size_t)b * SEQ * NIN + C_SBK + 64 * hd; const bf16_t* Vg = hb + (size_t)b * SEQ * NIN + C_SBV + 64 * hd;
    LAS char* Kl = lds + wave * 9216; LAS char* Vl = Kl + 4608;
    f32x16 o[2]; zero_o(o);
    float carry = 0.f;
    for (int st = q0w >> 5; st >= 0; --st) {
        const int kbase = 32 * st;
        u32x4 kr[4], vr[4];
#pragma unroll
        for (int jj = 0; jj < 4; ++jj) { const int ch = lane + 64 * jj, key = ch >> 3, cc = ch & 7;
            kr[jj] = *(const u32x4*)(Kg + (size_t)(kbase + key) * NIN + 8 * cc); vr[jj] = *(const u32x4*)(Vg + (size_t)(kbase + key) * NIN + 8 * cc); }
        asm volatile("" ::: "memory");
#pragma unroll
        for (int jj = 0; jj < 4; ++jj) { const int ch = lane + 64 * jj, key = ch >> 3, cc = ch & 7;
            *(LAS u32x4*)(Kl + key * KP + 16 * cc) = kr[jj]; *(LAS u32x4*)(Vl + key * KP + 16 * cc) = vr[jj]; }
        LDS_WAIT(); asm volatile("" ::: "memory");
        const f32x16 s = qk_rows<0, 4>(Kl, 0, qf, r, h);
        float l1m[16], ls[16];
        unsigned vm = 0;
#pragma unroll
        for (int i = 0; i < 16; ++i) { const int kidx = kbase + (i & 3) + 8 * (i >> 2) + 4 * h; const bool ok = kidx < qpos; vm |= ok ? (1u << i) : 0u;
            const float z = s[i] * 0.125f; const float sp = fmaxf(z, 0.f) + __logf(1.0f + __expf(-fabsf(z)));
            l1m[i] = ok ? -sp : 0.f; ls[i] = z - sp; }
        float G[4], Gp[4], tot[4];
#pragma unroll
        for (int g = 0; g < 4; ++g) { G[g] = (l1m[4 * g] + l1m[4 * g + 1]) + (l1m[4 * g + 2] + l1m[4 * g + 3]); Gp[g] = shx32(G[g], lane); tot[g] = G[g] + Gp[g]; }
        float aft[4];
        aft[3] = (h == 0) ? Gp[3] : 0.f;
        aft[2] = tot[3] + ((h == 0) ? Gp[2] : 0.f);
        aft[1] = tot[3] + tot[2] + ((h == 0) ? Gp[1] : 0.f);
        aft[0] = tot[3] + tot[2] + tot[1] + ((h == 0) ? Gp[0] : 0.f);
        float p[16];
#pragma unroll
        for (int g = 0; g < 4; ++g) {
            const float base = carry + aft[g];
            const float w3 = 0.f, w2 = l1m[4 * g + 3], w1 = w2 + l1m[4 * g + 2], w0 = w1 + l1m[4 * g + 1];
            p[4 * g + 0] = ((vm >> (4 * g + 0)) & 1u) ? __expf(ls[4 * g + 0] + base + w0) : 0.f;
            p[4 * g + 1] = ((vm >> (4 * g + 1)) & 1u) ? __expf(ls[4 * g + 1] + base + w1) : 0.f;
            p[4 * g + 2] = ((vm >> (4 * g + 2)) & 1u) ? __expf(ls[4 * g + 2] + base + w2) : 0.f;
            p[4 * g + 3] = ((vm >> (4 * g + 3)) & 1u) ? __expf(ls[4 * g + 3] + base + w3) : 0.f;
        }
        carry += (tot[0] + tot[1]) + (tot[2] + tot[3]);
        bf16x8 pf[2]; pack_p(p, pf);
        pv_rows(o, Vl, 0, pf, lane);
        asm volatile("" ::: "memory");
        if (__builtin_amdgcn_ballot_w64(carry >= -120.0f) == 0ull) break;
    }
    store_o((bf16_t*)(P.ws + WS_O) + ((size_t)0 * TOK + (size_t)b * SEQ + qpos) * 256 + 64 * hd, o, h);
}

DI void diff_unit(const Params& P, int l, LAS char* lds, int b, int hd, int qb, int tid, int wave, int lane) {
    const bf16_t* hb = (const bf16_t*)(P.ws + WS_H);
    const int r = lane & 31, h = lane >> 5, q0w = 256 * qb + 32 * wave, qpos = q0w + r;
    bf16x8 qf[4]; load_q(qf, hb + (size_t)(b * SEQ + qpos) * NIN + C_DFQ + 64 * hd, h);
    Stage2 st0; flash_prefetch(st0, hb + (size_t)b * SEQ * NIN + C_DFK + 64 * hd, hb + (size_t)b * SEQ * NIN + C_DFV + 64 * hd, NIN, 0, 4 * qb + 3, tid);
    norm_rope_q<true>(qf, P.in[3] + (size_t)l * 32, 0.17677669529663687f * LOG2E, qpos & (SEQ - 1), h, lane);
    const bf16_t* Kg = hb + (size_t)b * SEQ * NIN + C_DFK + 64 * hd; const bf16_t* Vg = hb + (size_t)b * SEQ * NIN + C_DFV + 64 * hd;
    f32x16 o1[2], o2[2]; zero_o(o1); zero_o(o2);
    float m1 = -1e30f, l1 = 0.f, m2 = -1e30f, l2 = 0.f;
    flash_tiles<MODE_DIFF, true>(lds, Kg, Vg, NIN, 0, 4 * qb + 3, qf, qpos, q0w, 0ull, 1.0f, m1, l1, o1, m2, l2, o2, tid, lane, st0);
    const float* lp = P.in[5] + (size_t)l * 4 * 32;
    float s01 = (lane < 32) ? lp[lane] * lp[32 + lane] : 0.f, s23 = (lane < 32) ? lp[64 + lane] * lp[96 + lane] : 0.f;
    s01 = wave_sum(s01, lane); s23 = wave_sum(s23, lane);
    float lf = (float)l; asm volatile("" : "+v"(lf));
    const float lam_init = 0.8f - 0.6f * expf(-0.3f * lf);
    const float lam = expf(s01) - expf(s23) + lam_init;
    const float i1 = 1.0f / l1, i2 = lam / l2;
    float ss = 0.f;
#pragma unroll
    for (int dt = 0; dt < 2; ++dt)
#pragma unroll
        for (int i = 0; i < 16; ++i) { const float v = o1[dt][i] * i1 - o2[dt][i] * i2; o1[dt][i] = v; ss += v * v; }
    ss += shx32(ss, lane);
    const float rstd = (1.0f - lam_init) / sqrtf(ss * (1.0f / 64.0f) + RMS_EPS);
    const float* sg = P.in[6] + (size_t)l * 64;
#pragma unroll
    for (int dt = 0; dt < 2; ++dt)
#pragma unroll
        for (int i = 0; i < 16; ++i) o1[dt][i] = o1[dt][i] * rstd * sg[32 * dt + (i & 3) + 8 * (i >> 2) + 4 * h];
    store_o((bf16_t*)(P.ws + WS_O) + ((size_t)1 * TOK + (size_t)b * SEQ + qpos) * 256 + 64 * hd, o1, h);
}

DI void moba_unit(const Params& P, int l, LAS char* lds, int b, int hd, int qb, int tid, int wave, int lane) {
    const bf16_t* hb = (const bf16_t*)(P.ws + WS_H);
    const int r = lane & 31, h = lane >> 5, q0w = 256 * qb + 32 * wave, qpos = q0w + r;
    LAS float* kmL = (LAS float*)(lds + 8 * TILE_B);
    const float* kmg = (const float*)(P.ws + WS_KMEAN) + (size_t)(b * 4 + hd) * 16 * 4 * 64;
#pragma unroll
    for (int u = 0; u < 2; ++u) { const int e = tid + 512 * u, nb = e >> 6, d = e & 63; const float* q4 = kmg + (size_t)nb * 256 + d;
        kmL[e] = (((q4[0] + q4[64]) + q4[128]) + q4[192]) * (1.0f / 256.0f); }
    __syncthreads();
    bf16x8 qf[4]; load_q(qf, hb + (size_t)(b * SEQ + qpos) * NIN + C_MBQ + 64 * hd, h);
    Stage2 st0; flash_prefetch(st0, hb + (size_t)b * SEQ * NIN + C_MBK + 64 * hd, hb + (size_t)b * SEQ * NIN + C_MBV + 64 * hd, NIN, 0, 4 * qb + 3, tid);
    norm_rope_q<false>(qf, P.in[7] + (size_t)l * 64, 0.125f * LOG2E, qpos, h, lane);
    float qv[4][8];
#pragma unroll
    for (int ks = 0; ks < 4; ++ks) unpack8(__builtin_bit_cast(u32x4, qf[ks]), qv[ks]);
    float v0 = -3e38f, v1 = -3e38f, v2 = -3e38f; int i0 = -1, i1 = -1, i2 = -1;
#pragma unroll 1
    for (int n = 0; n < qb; ++n) {
        float g = 0.f;
#pragma unroll
        for (int ks = 0; ks < 4; ++ks) { const f32x4 a = *(LAS const f32x4*)(kmL + n * 64 + 16 * ks + 8 * h), bq = *(LAS const f32x4*)(kmL + n * 64 + 16 * ks + 8 * h + 4);
            g += (qv[ks][0] * a[0] + qv[ks][1] * a[1]) + (qv[ks][2] * a[2] + qv[ks][3] * a[3]) + (qv[ks][4] * bq[0] + qv[ks][5] * bq[1]) + (qv[ks][6] * bq[2] + qv[ks][7] * bq[3]); }
        g += shx32(g, lane);
        if (g > v0) { v2 = v1; i2 = i1; v1 = v0; i1 = i0; v0 = g; i0 = n; }
        else if (g > v1) { v2 = v1; i2 = i1; v1 = g; i1 = n; }
        else if (g > v2) { v2 = g; i2 = n; }
    }
    unsigned bm = 0;
    if (i0 >= 0) bm |= 1u << i0;
    if (i1 >= 0) bm |= 1u << i1;
    if (i2 >= 0) bm |= 1u << i2;
    bm |= 1u << qb;
    f32x16 o[2], od[2]; zero_o(o);
    float m = -1e30f, lsum = 0.f, md = 0.f, ld = 0.f;
    flash_tiles<MODE_MOBA, true>(lds, hb + (size_t)b * SEQ * NIN + C_MBK + 64 * hd, hb + (size_t)b * SEQ * NIN + C_MBV + 64 * hd, NIN, 0, 4 * qb + 3, qf, qpos, q0w,
                           (unsigned long long)bm, 1.0f, m, lsum, o, md, ld, od, tid, lane, st0);
    const float inv = 1.0f / lsum;
#pragma unroll
    for (int i = 0; i < 16; ++i) { o[0][i] *= inv; o[1][i] *= inv; }
    store_o((bf16_t*)(P.ws + WS_O) + ((size_t)2 * TOK + (size_t)b * SEQ + qpos) * 256 + 64 * hd, o, h);
}

constexpr int NSA_IMP = 73728, NSA_SELM = NSA_IMP + 65536;
DI void nsa_unit(const Params& P, int l, LAS char* lds, int b, int qt, int tid, int wave, int lane) {
    const bf16_t* hb = (const bf16_t*)(P.ws + WS_H);
    const int r = lane & 31, h = lane >> 5, hd = wave & 3, qh = wave >> 2, q0w = 64 * qt + 32 * qh, qpos = q0w + r;
    const bf16_t* hrow = hb + (size_t)(b * SEQ + qpos) * NIN;
    bf16x8 qf[4]; load_q(qf, hrow + C_NSQ + 64 * hd, h);
    norm_rope_q<false>(qf, P.in[9] + (size_t)l * 64, 0.125f * LOG2E, qpos, h, lane);
    const float g_c = sigmoidf_(bf2f(hrow[C_NSG + 0 + hd])), g_s = sigmoidf_(bf2f(hrow[C_NSG + 4 + hd])), g_w = sigmoidf_(bf2f(hrow[C_NSG + 8 + hd]));
    const float c = 1.0f;
    LAS char* kcL = lds; LAS char* vcL = lds + 256 * KP;
    LAS float* impH = (LAS float*)(lds + NSA_IMP);
    const int nst = ((4 * qt + 2) >> 5) + 1;
    {
        const bf16_t* kcg = (const bf16_t*)(P.ws + WS_KC) + (size_t)b * 256 * 64; const bf16_t* vcg = (const bf16_t*)(P.ws + WS_VC) + (size_t)b * 256 * 64;
        for (int ch = tid; ch < 32 * nst * 8; ch += 512) { const int key = ch >> 3, cc = ch & 7;
            *(LAS u32x4*)(kcL + key * KP + 16 * cc) = *(const u32x4*)(kcg + (size_t)key * 64 + 8 * cc); *(LAS u32x4*)(vcL + key * KP + 16 * cc) = *(const u32x4*)(vcg + (size_t)key * 64 + 8 * cc); }
    }
    __syncthreads();
    f32x16 otot[2], o[2]; zero_o(otot); zero_o(o);
    float m = -1e30f, lsum = 0.f;
    for (int st = 0; st < nst; ++st) {
        const f32x16 s = qk_rows<0, 4>(kcL, 32 * st, qf, r, h);
        float t[16], mx = -1e30f;
#pragma unroll
        for (int i = 0; i < 16; ++i) { const int n = 32 * st + (i & 3) + 8 * (i >> 2) + 4 * h; const bool ok = (16 * n + 31 <= qpos); t[i] = ok ? s[i] * c : -1e30f; mx = fmaxf(mx, t[i]); }
        mx = fmaxf(mx, shx32(mx, lane));
        const float mn = fmaxf(m, mx), alpha = ex2(m - mn);
        float rs = 0.f;
#pragma unroll
        for (int i = 0; i < 16; ++i) rs += (t[i] > -1e29f) ? ex2(t[i] - mn) : 0.f;
        rs += shx32(rs, lane);
        lsum = lsum * alpha + rs; m = mn;
    }
    const float linv = lsum > 0.f ? 1.0f / lsum : 0.f;
    float prevpc3 = 0.f;
    for (int st = 0; st < nst; ++st) {
        const f32x16 s = qk_rows<0, 4>(kcL, 32 * st, qf, r, h);
        float p[16];
#pragma unroll
        for (int i = 0; i < 16; ++i) { const int n = 32 * st + (i & 3) + 8 * (i >> 2) + 4 * h; const bool ok = (16 * n + 31 <= qpos); p[i] = ok ? ex2(s[i] * c - m) * linv : 0.f; }
        float pc[4];
#pragma unroll
        for (int g = 0; g < 4; ++g) pc[g] = shx32(p[4 * g + 3], lane);
#pragma unroll
        for (int g = 0; g < 4; ++g) {
            const float a = 2.0f * ((p[4 * g] + p[4 * g + 1]) + p[4 * g + 2]) + p[4 * g + 3];
            const float pred = (h == 1) ? pc[g] : (g > 0 ? pc[g > 0 ? g - 1 : 0] : prevpc3);
            impH[(hd * 64 + 32 * qh + r) * 64 + 8 * st + 2 * g + h] = a + pred;
        }
        prevpc3 = pc[3];
        bf16x8 pf[2]; pack_p(p, pf);
        pv_rows(o, vcL, 32 * st, pf, lane);
    }
#pragma unroll
    for (int i = 0; i < 16; ++i) { otot[0][i] = g_c * o[0][i]; otot[1][i] = g_c * o[1][i]; }
    __syncthreads();
    Stage2 stS; flash_prefetch(stS, hb + (size_t)b * SEQ * NIN + C_KS, hb + (size_t)b * SEQ * NIN + C_VS, NIN, 0, qt, tid);
    {
        LAS float* impS = (LAS float*)lds;
        LAS unsigned long long* selm = (LAS unsigned long long*)(lds + NSA_SELM);
        const int q = tid >> 3, s8 = tid & 7;
        if (qt <= 15) { if (s8 == 0) selm[q] = (2ull << qt) - 1ull; }
        else {
#pragma unroll
            for (int e = 0; e < 8; ++e) { const int J = 8 * s8 + e; impS[q * 65 + J] = ((impH[(0 * 64 + q) * 64 + J] + impH[(1 * 64 + q) * 64 + J]) + impH[(2 * 64 + q) * 64 + J]) + impH[(3 * 64 + q) * 64 + J]; }
            __syncthreads();
            unsigned bits = 0;
#pragma unroll
            for (int e = 0; e < 8; ++e) {
                const int J = 8 * s8 + e;
                if (J >= 1 && J <= qt - 2) {
                    const float v = impS[q * 65 + J]; int cnt = 0;
                    for (int J2 = 1; J2 <= qt - 2; ++J2) { const float v2 = impS[q * 65 + J2]; cnt += (v2 > v || (v2 == v && J2 < J)) ? 1 : 0; }
                    if (cnt < 13) bits |= 1u << e;
                }
            }
            unsigned lo = (s8 < 4) ? (bits << (8 * s8)) : 0u, hi = (s8 >= 4) ? (bits << (8 * (s8 - 4))) : 0u;
            lo |= shxu(lo, 1, lane); lo |= shxu(lo, 2, lane); lo |= shxu(lo, 4, lane);
            hi |= shxu(hi, 1, lane); hi |= shxu(hi, 2, lane); hi |= shxu(hi, 4, lane);
            if (s8 == 0) selm[q] = ((unsigned long long)hi << 32) | (unsigned long long)lo | 1ull | (1ull << (qt - 1)) | (1ull << qt);
        }
    }
    __syncthreads();
    const unsigned long long sel = ((LAS const unsigned long long*)(lds + NSA_SELM))[32 * qh + r];
    float md = 0.f, ld = 0.f; f32x16 od[2];
    LAS float* stash = (LAS float*)(lds + NSA_IMP) + wave * 2048 + lane;
#pragma unroll
    for (int i = 0; i < 16; ++i) { stash[i * 64] = otot[0][i]; stash[(16 + i) * 64] = otot[1][i]; }
    zero_o(o); m = -1e30f; lsum = 0.f;
    flash_tiles<MODE_NSEL, true>(lds, hb + (size_t)b * SEQ * NIN + C_KS, hb + (size_t)b * SEQ * NIN + C_VS, NIN, 0, qt, qf, qpos, q0w, sel, c, m, lsum, o, md, ld, od, tid, lane, stS);
    { const float f = g_s / lsum;
#pragma unroll
      for (int i = 0; i < 16; ++i) { stash[i * 64] += f * o[0][i]; stash[(16 + i) * 64] += f * o[1][i]; } }
    zero_o(o); m = -1e30f; lsum = 0.f;
    flash_tiles<MODE_NWIN>(lds, hb + (size_t)b * SEQ * NIN + C_KW, hb + (size_t)b * SEQ * NIN + C_VW, NIN, qt > 8 ? qt - 8 : 0, qt, qf, qpos, q0w, 0ull, c, m, lsum, o, md, ld, od, tid, lane, stS);
    { const float f = g_w / lsum;
#pragma unroll
      for (int i = 0; i < 16; ++i) { otot[0][i] = stash[i * 64] + f * o[0][i]; otot[1][i] = stash[(16 + i) * 64] + f * o[1][i]; } }
    store_o((bf16_t*)(P.ws + WS_O) + ((size_t)3 * TOK + (size_t)b * SEQ + qpos) * 256 + 64 * hd, otot, h);
}

#define UNIT_LOOP(BODY) _Pragma("unroll 1") for (int k = 0; k * G < 512; ++k) { const int j = k * G + ((k & 1) ? (G - 1 - cblk) : cblk); if (j >= 512) continue; __syncthreads(); \
    int tid_ = wave_s * 64 + fresh_lane(); const int tid = tid_, lane = tid & 63, wave = wave_s; (void)tid; \
    const int bh = j & 31, qb = 15 - (j >> 5), b = bh >> 2, hd = bh & 3; (void)qb; (void)b; (void)hd; BODY; }
DI void attn_phase(const Params& P, int l, LAS char* lds, int G, int cblk, const int wave_s) {
    if (PH_MASK & 16u) { UNIT_LOOP(nsa_unit(P, l, lds, j & 7, 63 - (j >> 3), tid, wave, lane)) }
    if (PH_MASK & 32u) { UNIT_LOOP(diff_unit(P, l, lds, b, hd, qb, tid, wave, lane)) }
    if (PH_MASK & 64u) { UNIT_LOOP(moba_unit(P, l, lds, b, hd, qb, tid, wave, lane)) }
    if (PH_MASK & 128u) { UNIT_LOOP(sb_unit(P, lds, b, hd, qb, wave, lane)) }
}
__global__ void __launch_bounds__(NWAVES * 64 LB2) fwd_kernel(Params P) {
    extern __shared__ __attribute__((aligned(16))) unsigned char lds_raw[];
    cg::grid_group grid = cg::this_grid();
    LAS unsigned char* lds = (LAS unsigned char*)lds_raw;
    const int G = gridDim.x, bx = blockIdx.x;
    const int wave_s = __builtin_amdgcn_readfirstlane((int)threadIdx.x >> 6);
    if (threadIdx.x < 16) ((LAS unsigned*)(lds + LDS_BYTES - 64))[threadIdx.x] = 0u;
    __syncthreads();
    const XcdBarrier xbar = xcd_barrier_post((unsigned*)P.ws, (volatile LAS unsigned*)(lds + LDS_BYTES - 64));
    const int vcu = (G % 8 == 0) ? (bx % 8) * (G / 8) + bx / 8 : bx;
    const int NGW = G * NWAVES;
#define FRESH_IDS() int tid_ = wave_s * 64 + fresh_lane(); const int tid = tid_, lane = tid & 63, wave = __builtin_amdgcn_readfirstlane(tid >> 6), gw = vcu * NWAVES + wave; (void)gw; (void)lane; (void)tid
    bf16_t* XN = (bf16_t*)(P.ws + WS_XN); bf16_t* HB = (bf16_t*)(P.ws + WS_H); bf16_t* OB = (bf16_t*)(P.ws + WS_O); bf16_t* TB = (bf16_t*)(P.ws + WS_T);
    bf16_t* MG = (bf16_t*)(P.ws + WS_O); float* X1 = (float*)(P.ws + WS_X1); bf16_t* AB = (bf16_t*)(P.ws + WS_A);

    { FRESH_IDS(); if (PH_MASK & 1u) prologue_phase(P, lds, gw, NGW, wave, lane); }
    { FRESH_IDS(); rms_phase(P.in[0], P.in[1], XN, gw, NGW, lane); }
    if (P.ws == nullptr) grid.sync();
    xcd_barrier(xbar, wave_s);
#ifdef PROBE_SYNC
#define GSYNC() do { xcd_barrier(xbar, wave_s); xcd_barrier(xbar, wave_s); xcd_barrier(xbar, wave_s); } while (0)
#else
#define GSYNC() xcd_barrier(xbar, wave_s)
#endif
#pragma unroll 1
    for (int l = 0; l < DEPTH; ++l) {
        const float* xin = (l == 0) ? P.in[0] : (const float*)P.out;
        unsigned char* wl = P.ws + WS_W + (size_t)l * WL_STRIDE;
        if (l > 0) { FRESH_IDS(); rms_phase(xin, P.in[1] + (size_t)l * DM, XN, gw, NGW, lane); GSYNC(); }
        {
            pg8::Gemm g{XN, (const bf16_t*)(wl + WL_IN), TOK, NIN, DM}; pg8::StaticOrder S; S.init(TOK, NIN, G, bx);
            pg8::EpiStore E{HB, NIN};
            if (((PH_MASK & 8u) != 0u) & ((GEMM_SEL & 1u) != 0u)) pg8::gemm_phase<pg8::EpiStore, pg8::StaticOrder, true, true>(lds, g, S, E, wave_s);
#ifdef PROBE_GEMM2
            __syncthreads();
            if (((PH_MASK & 8u) != 0u) & ((GEMM_SEL & 1u) != 0u)) pg8::gemm_phase<pg8::EpiStore, pg8::StaticOrder, true, true>(lds, g, S, E, wave_s);
#endif
        }
        GSYNC();
        if (PH_MASK & 2u) { FRESH_IDS(); prep_phase(P, l, lds, G, bx, gw, NGW, wave, lane); }
        GSYNC();
        if (PH_MASK & 4u) { attn_phase(P, l, (LAS char*)lds, G, bx, wave_s); }
#ifdef PROBE_ATTN2
        grid.sync(); attn_phase(P, l, (LAS char*)lds, G, bx, wave_s);
#endif
        GSYNC();
        {
            pg8::Gemm g{OB, (const bf16_t*)(wl + WL_B), 4 * TOK, 4096, 256}; pg8::DiagOrder S{G, bx};
            pg8::EpiT E{TB};
            if (((PH_MASK & 8u) != 0u) & ((GEMM_SEL & 2u) != 0u)) pg8::gemm_phase<pg8::EpiT, pg8::DiagOrder, true, true>(lds, g, S, E, wave_s);
#ifdef PROBE_GEMM2
            __syncthreads();
            if (((PH_MASK & 8u) != 0u) & ((GEMM_SEL & 2u) != 0u)) pg8::gemm_phase<pg8::EpiT, pg8::DiagOrder, true, true>(lds, g, S, E, wave_s);
#endif
        }
        GSYNC();
        {
            pg8::Gemm g{XN, (const bf16_t*)(wl + WL_G), TOK, 4096, DM}; pg8::StaticOrder S; S.init(TOK, 4096, G, bx);
            pg8::EpiMerge E{TB, P.in[14] + (size_t)l * 4 * DM, MG};
            if (((PH_MASK & 8u) != 0u) & ((GEMM_SEL & 4u) != 0u)) pg8::gemm_phase<pg8::EpiMerge, pg8::StaticOrder, true, true>(lds, g, S, E, wave_s);
#ifdef PROBE_GEMM2
            __syncthreads();
            if (((PH_MASK & 8u) != 0u) & ((GEMM_SEL & 4u) != 0u)) pg8::gemm_phase<pg8::EpiMerge, pg8::StaticOrder, true, true>(lds, g, S, E, wave_s);
#endif
        }
        GSYNC();
        {
            pg8::Gemm g{MG, (const bf16_t*)(wl + WL_O), TOK, DM, DM}; pg8::StaticOrder S; S.init(TOK, DM, G, bx);
            pg8::EpiResid E{xin, X1};
            if (((PH_MASK & 8u) != 0u) & ((GEMM_SEL & 8u) != 0u)) pg8::gemm_phase<pg8::EpiResid, pg8::StaticOrder, true, true>(lds, g, S, E, wave_s);
#ifdef PROBE_GEMM2
            __syncthreads();
            if (((PH_MASK & 8u) != 0u) & ((GEMM_SEL & 8u) != 0u)) pg8::gemm_phase<pg8::EpiResid, pg8::StaticOrder, true, true>(lds, g, S, E, wave_s);
#endif
        }
        GSYNC();
        { FRESH_IDS(); rms_phase(X1, P.in[17] + (size_t)l * DM, XN, gw, NGW, lane); }
        GSYNC();
        {
            pg8::Gemm g{XN, (const bf16_t*)(wl + WL_GU), TOK, NGU, DM}; pg8::StaticOrder S; S.init(TOK, NGU, G, bx);
            pg8::EpiSwiGLU E{AB};
            if (((PH_MASK & 8u) != 0u) & ((GEMM_SEL & 16u) != 0u)) pg8::gemm_phase<pg8::EpiSwiGLU, pg8::StaticOrder, true, true>(lds, g, S, E, wave_s);
#ifdef PROBE_GEMM2
            __syncthreads();
            if (((PH_MASK & 8u) != 0u) & ((GEMM_SEL & 16u) != 0u)) pg8::gemm_phase<pg8::EpiSwiGLU, pg8::StaticOrder, true, true>(lds, g, S, E, wave_s);
#endif
        }
        GSYNC();
        {
            pg8::Gemm g{AB, (const bf16_t*)(wl + WL_D), TOK, DM, FF}; pg8::StaticOrder S; S.init(TOK, DM, G, bx);
            pg8::EpiResid E{X1, P.out};
            if (((PH_MASK & 8u) != 0u) & ((GEMM_SEL & 32u) != 0u)) pg8::gemm_phase<pg8::EpiResid, pg8::StaticOrder, true, true>(lds, g, S, E, wave_s);
#ifdef PROBE_GEMM2
            __syncthreads();
            if (((PH_MASK & 8u) != 0u) & ((GEMM_SEL & 32u) != 0u)) pg8::gemm_phase<pg8::EpiResid, pg8::StaticOrder, true, true>(lds, g, S, E, wave_s);
#endif
        }
        if (l + 1 < DEPTH) GSYNC();
    }
}

extern "C" void kernel_launch(void* const* d_in, const int* in_sizes, int n_in, void* d_out, int out_size, void* d_ws, size_t ws_size, hipStream_t stream) {
    static int grid = 0;
    if (grid == 0) {
        if (n_in != 21 || ws_size < WS_END) { fprintf(stderr, "kernel_launch: unexpected n_in %d / ws %zu\n", n_in, ws_size); grid = -1; return; }
        int dev = 0, cus = 0, per_cu = 0;
        (void)hipGetDevice(&dev); (void)hipDeviceGetAttribute(&cus, hipDeviceAttributeMultiprocessorCount, dev);
        (void)hipFuncSetAttribute((const void*)fwd_kernel, hipFuncAttributeMaxDynamicSharedMemorySize, LDS_BYTES);
        (void)hipOccupancyMaxActiveBlocksPerMultiprocessor(&per_cu, (const void*)fwd_kernel, NWAVES * 64, LDS_BYTES);
        if (per_cu < 1) per_cu = 1;
        grid = cus * 1;
        (void)hipGetLastError();
    }
    if (grid < 0) return;
    if (hipMemsetAsync(d_ws, 0, 16384, stream) != hipSuccess) { fprintf(stderr, "kernel_launch: memset of the barrier words failed\n"); return; }
    Params p{};
    for (int i = 0; i < 21; ++i) p.in[i] = (const float*)d_in[i];
    p.out = (float*)d_out; p.ws = (unsigned char*)d_ws;
    void* args[] = {&p};
    hipError_t e = hipLaunchCooperativeKernel((const void*)fwd_kernel, dim3(grid), dim3(NWAVES * 64), args, LDS_BYTES, stream);
    if (e != hipSuccess) fprintf(stderr, "cooperative launch failed: %s (grid %d)\n", hipGetErrorString(e), grid);
}
```

```cpp
#include <hip/hip_runtime.h>
#include <hip/hip_cooperative_groups.h>
#include <cstdio>
#include <cstdint>
namespace cg = cooperative_groups;
#define PG8_LAS __attribute__((address_space(3)))
#define LAS __attribute__((address_space(3)))
#define DI __device__ __forceinline__
#ifndef GEMM_SEL
#define GEMM_SEL 0xffu
#endif
#ifndef LB2
#define LB2
#endif
#ifndef PH_MASK
#define PH_MASK 0xffffffffu
#endif
__device__ __forceinline__ int fresh_lane() { int l; asm volatile("v_mbcnt_lo_u32_b32 %0, -1, 0\n\tv_mbcnt_hi_u32_b32 %0, -1, %0" : "=v"(l)); return l; }
#ifndef DIFF_MERGED
#define DIFF_MERGED 0
#endif
#ifndef PIPE64
#define PIPE64 1
#endif
namespace pg8 {
typedef unsigned short bf16_t;
typedef short bf16x8 __attribute__((ext_vector_type(8)));
typedef float f32x4 __attribute__((ext_vector_type(4)));
typedef unsigned u32x4 __attribute__((ext_vector_type(4)));
constexpr int BM = 256, BK = 64, HALF = 128, HTB = HALF * BK * 2  , STAGE_BYTES = 8 * HTB, NXCD = 8, WGM = 8;

__host__ __device__ __forceinline__ int lds_byte(int r, int c) { const int st = (r >> 4) * 2 + (c >> 5), rr = r & 15, cc = c & 31, ob = rr * 64 + cc * 2; return st * 1024 + (ob ^ (((ob >> 9) & 1) << 5)); }
__host__ __device__ __forceinline__ void stage_rc(int b, int& R, int& C) { const int st = b / 1024, sb = b % 1024, swz = sb ^ (((sb >> 9) & 1) << 5); R = (st >> 1) * 16 + swz / 64; C = (st & 1) * 32 + (swz % 64) / 2; }
__host__ __device__ __forceinline__ int perm32(int rho) { const int n = rho >> 4, i = rho & 15; return 8 * (i >> 2) + 4 * n + (i & 3); }

struct Unit { int pm, pn; };
struct Gemm { const bf16_t* A; const bf16_t* Bt; int M, N, K; };

struct StaticOrder {
    int nM, nN, nwg, G, c;
    __host__ __device__ void init(int M, int N, int G_, int c_) { nM = M / BM; nN = N / BM; nwg = nM * nN; G = G_; c = c_; }
    __host__ __device__ bool next(int i, Unit& u) const {
        const long L = (long)i * G + c; if (L >= nwg) return false;
        int wgid = (int)L; { const int q = nwg / NXCD, r = nwg % NXCD, xcd = wgid % NXCD, off = wgid / NXCD; wgid = (xcd < r ? xcd * (q + 1) : r * (q + 1) + (xcd - r) * q) + off; }
        const int nig = WGM * nN, gid = wgid / nig, fm = gid * WGM, gsz = (nM - fm) < WGM ? (nM - fm) : WGM;
        u.pm = fm + ((wgid % nig) % gsz); u.pn = (wgid % nig) / gsz; return true;
    }
    __device__ __forceinline__ void a_ready(const Unit&) const {}
    __device__ __forceinline__ void done(const Unit&) const {}
};
__device__ __forceinline__ unsigned cvt_pk_bf16(float lo, float hi) { unsigned r; asm volatile("v_cvt_pk_bf16_f32 %0, %1, %2" : "=v"(r) : "v"(lo), "v"(hi)); return r; }
template <class Epi, class Sched, bool ALIGN_EPI = false, bool SP2 = false>
__device__ __forceinline__ void gemm_phase(PG8_LAS unsigned char* lds, const Gemm g, const Sched& S, const Epi& E, const int wave_s) {
    int tid_ = wave_s * 64 + fresh_lane();
    const int tid = tid_, wid = __builtin_amdgcn_readfirstlane(tid >> 6), lane = tid & 63, wr = wid >> 2, wc = wid & 3, fr = lane & 15, fq = lane >> 4;
    int K_ = g.K; asm volatile("" : "+s"(K_));
    const int K = K_, nt = K / BK;
    unsigned voffA[2], voffB[2];
#pragma unroll
    for (int i = 0; i < 2; ++i) { int R, C; stage_rc(tid * 16 + i * 8192, R, C); const int Rb = Epi::PERM ? ((R & ~31) + perm32(R & 31)) : R;
        voffA[i] = (unsigned)(R * K + C) * 2u; voffB[i] = (unsigned)(Rb * K + C) * 2u; }
    const size_t kstep = (size_t)(BK * 2);
    const size_t hstep = (size_t)HALF * K * 2;
    const size_t tstep = 2 * hstep;
    const unsigned ldsw = (unsigned)wid * 1024u;
    const int aoff = lds_byte(wr * 64 + fr, fq * 8), boff = lds_byte(wc * 32 + fr, fq * 8);
#define PG8_SA(b, h) (((b) * 2 + (h)) * HTB)
#define PG8_SB(b, h) ((4 + (b) * 2 + (h)) * HTB)
#define PG8_STAGE(bufoff, gbase, voff) do { _Pragma("unroll") for (int _i = 0; _i < 2; ++_i) \
        __builtin_amdgcn_global_load_lds((const unsigned*)((const char*)(gbase) + (voff)[_i]), (PG8_LAS unsigned*)(lds + (bufoff) + ldsw + _i * 8192), 16, 0, 0); } while (0)
#define PG8_LDA(dst, b, h) do { _Pragma("unroll") for (int m = 0; m < 4; ++m) _Pragma("unroll") for (int k = 0; k < 2; ++k) dst[m][k] = *(const PG8_LAS bf16x8*)(lds + PG8_SA(b, h) + aoff + m * 2048 + k * 1024); } while (0)
#define PG8_LDB(dst, b, h) do { _Pragma("unroll") for (int n = 0; n < 2; ++n) _Pragma("unroll") for (int k = 0; k < 2; ++k) dst[n][k] = *(const PG8_LAS bf16x8*)(lds + PG8_SB(b, h) + boff + n * 2048 + k * 1024); } while (0)
#define PG8_MMA(ai, bj, At, Bt) do { __builtin_amdgcn_s_setprio(1); _Pragma("unroll") for (int m = 0; m < 4; ++m) _Pragma("unroll") for (int n = 0; n < 2; ++n) _Pragma("unroll") for (int k = 0; k < 2; ++k) \
        acc[ai][bj][m][n] = __builtin_amdgcn_mfma_f32_16x16x32_bf16(Bt[n][k], At[m][k], acc[ai][bj][m][n], 0, 0, 0); __builtin_amdgcn_s_setprio(0); } while (0)
#define PG8_WAIT_V(n) asm volatile("s_waitcnt vmcnt(" #n ")" ::: "memory")
#define PG8_WAIT_L(n) asm volatile("s_waitcnt lgkmcnt(" #n ")" ::: "memory")
#define PG8_BAR __builtin_amdgcn_s_barrier()
#define PG8_SCHED __builtin_amdgcn_sched_barrier(0)
    Unit cur, nxt; int ui = 0;
    if (!S.next(0, cur)) return;
    f32x4 acc[2][2][4][2];
#pragma unroll
    for (int a = 0; a < 2; ++a)
#pragma unroll
        for (int b = 0; b < 2; ++b)
#pragma unroll
            for (int m = 0; m < 4; ++m)
#pragma unroll
                for (int n = 0; n < 2; ++n) acc[a][b][m][n] = (f32x4){0.f, 0.f, 0.f, 0.f};
    bf16x8 At[4][2], B0[2][2], B1[2][2];
    const char* cA = (const char*)g.A + (size_t)cur.pm * tstep; const char* cB = (const char*)g.Bt + (size_t)cur.pn * tstep;
    S.a_ready(cur);
    if constexpr (SP2) {
        PG8_STAGE(PG8_SB(0, 0), cB, voffB); PG8_STAGE(PG8_SB(0, 1), cB + hstep, voffB); PG8_STAGE(PG8_SA(0, 0), cA, voffA); PG8_STAGE(PG8_SA(0, 1), cA + hstep, voffA);
        if (wr == 1) PG8_BAR;
        PG8_WAIT_V(2); PG8_BAR;
        PG8_STAGE(PG8_SB(1, 0), cB + kstep, voffB); PG8_STAGE(PG8_SA(1, 0), cA + kstep, voffA); PG8_STAGE(PG8_SB(1, 1), cB + hstep + kstep, voffB);
        PG8_WAIT_V(6); PG8_BAR;
    } else {
        PG8_STAGE(PG8_SB(0, 0), cB, voffB); PG8_STAGE(PG8_SA(0, 0), cA, voffA); PG8_STAGE(PG8_SB(0, 1), cB + hstep, voffB); PG8_STAGE(PG8_SA(0, 1), cA + hstep, voffA);
        if (wr == 1) PG8_BAR;
        PG8_WAIT_V(4); PG8_BAR;
        PG8_STAGE(PG8_SB(1, 0), cB + kstep, voffB); PG8_STAGE(PG8_SA(1, 0), cA + kstep, voffA); PG8_STAGE(PG8_SB(1, 1), cB + hstep + kstep, voffB);
        PG8_WAIT_V(6); PG8_BAR;
    }
    for (;;) {
        const bool has_next = S.next(ui + 1, nxt);
        const char* nA = has_next ? (const char*)g.A + (size_t)nxt.pm * tstep : cA; const char* nB = has_next ? (const char*)g.Bt + (size_t)nxt.pn * tstep : cB;
        for (int t = 0; t < nt; t += 2) {
            const bool last = (t == nt - 2);
            const char* a1 = cA + (size_t)(t + 1) * kstep;
            const char* a2 = last ? nA : cA + (size_t)(t + 2) * kstep; const char* b2 = last ? nB : cB + (size_t)(t + 2) * kstep;
            const char* a3 = a2 + kstep; const char* b3 = b2 + kstep;
            if (last && has_next) S.a_ready(nxt);
            if constexpr (SP2) {
            PG8_LDB(B0, 0, 0); PG8_LDB(B1, 0, 1); PG8_SCHED; PG8_LDA(At, 0, 0); PG8_STAGE(PG8_SA(1, 1), a1 + hstep, voffA);
            PG8_WAIT_V(8); PG8_WAIT_L(0); PG8_BAR; PG8_MMA(0, 0, At, B0); PG8_MMA(0, 1, At, B1); PG8_BAR; PG8_SCHED;
            PG8_LDA(At, 0, 1); PG8_STAGE(PG8_SB(0, 0), b2, voffB); PG8_STAGE(PG8_SB(0, 1), b2 + hstep, voffB); PG8_STAGE(PG8_SA(0, 0), a2, voffA);
            PG8_WAIT_V(8); PG8_WAIT_L(0); PG8_BAR; PG8_MMA(1, 0, At, B0); PG8_MMA(1, 1, At, B1); PG8_BAR; PG8_SCHED;
            PG8_LDB(B0, 1, 0); PG8_LDB(B1, 1, 1); PG8_SCHED; PG8_LDA(At, 1, 0); PG8_STAGE(PG8_SA(0, 1), a2 + hstep, voffA);
            PG8_WAIT_V(8); PG8_WAIT_L(0); PG8_BAR; PG8_MMA(0, 0, At, B0); PG8_MMA(0, 1, At, B1); PG8_BAR; PG8_SCHED;
            PG8_LDA(At, 1, 1); PG8_STAGE(PG8_SB(1, 0), b3, voffB); PG8_STAGE(PG8_SB(1, 1), b3 + hstep, voffB); PG8_STAGE(PG8_SA(1, 0), a3, voffA);
            PG8_WAIT_V(8); PG8_WAIT_L(0); PG8_BAR; PG8_MMA(1, 0, At, B0); PG8_MMA(1, 1, At, B1); PG8_BAR; PG8_SCHED;
            } else {
            PG8_LDB(B0, 0, 0); PG8_SCHED; PG8_LDA(At, 0, 0); PG8_STAGE(PG8_SA(1, 1), a1 + hstep, voffA);
            PG8_WAIT_L(8); PG8_BAR; PG8_WAIT_L(0); PG8_MMA(0, 0, At, B0); PG8_BAR; PG8_SCHED;
            PG8_LDB(B1, 0, 1); PG8_STAGE(PG8_SB(0, 0), b2, voffB);
            PG8_BAR; PG8_WAIT_L(0); PG8_MMA(0, 1, At, B1); PG8_BAR;
            PG8_LDA(At, 0, 1); PG8_STAGE(PG8_SA(0, 0), a2, voffA);
            PG8_BAR; PG8_WAIT_L(0); PG8_MMA(1, 0, At, B0); PG8_BAR; PG8_SCHED;
            PG8_STAGE(PG8_SB(0, 1), b2 + hstep, voffB);
            PG8_WAIT_V(6); PG8_BAR; PG8_MMA(1, 1, At, B1); PG8_BAR;
            PG8_LDB(B0, 1, 0); PG8_SCHED; PG8_LDA(At, 1, 0); PG8_STAGE(PG8_SA(0, 1), a2 + hstep, voffA);
            PG8_WAIT_L(8); PG8_BAR; PG8_WAIT_L(0); PG8_MMA(0, 0, At, B0); PG8_BAR; PG8_SCHED;
            PG8_LDB(B1, 1, 1); PG8_STAGE(PG8_SB(1, 0), b3, voffB);
            PG8_BAR; PG8_WAIT_L(0); PG8_MMA(0, 1, At, B1); PG8_BAR;
            PG8_LDA(At, 1, 1); PG8_STAGE(PG8_SA(1, 0), a3, voffA);
            PG8_BAR; PG8_WAIT_L(0); PG8_MMA(1, 0, At, B0); PG8_BAR; PG8_SCHED;
            PG8_STAGE(PG8_SB(1, 1), b3 + hstep, voffB);
            PG8_WAIT_V(6); PG8_BAR; PG8_MMA(1, 1, At, B1); PG8_BAR;
            }
        }
        if constexpr (ALIGN_EPI) { if (wr == 0) PG8_BAR; }
        if constexpr (!Epi::AFTER_DRAIN) { E(acc, cur, wr, wc, fr, fq); S.done(cur); }
        if (!has_next) break;
#pragma unroll
        for (int a = 0; a < 2; ++a)
#pragma unroll
            for (int b = 0; b < 2; ++b)
#pragma unroll
                for (int m = 0; m < 4; ++m)
#pragma unroll
                    for (int n = 0; n < 2; ++n) acc[a][b][m][n] = (f32x4){0.f, 0.f, 0.f, 0.f};
        cur = nxt; cA = nA; cB = nB; ++ui;
        if constexpr (ALIGN_EPI) { if (wr == 1) PG8_BAR; }
    }
    PG8_WAIT_V(0);
    if constexpr (!ALIGN_EPI) { if (wr == 0) PG8_BAR; }
    PG8_BAR;
    if constexpr (Epi::AFTER_DRAIN) { E.fused(acc, cur, wr, wc, fr, fq, lds, wid, lane); S.done(cur); }
#undef PG8_SA
#undef PG8_SB
#undef PG8_STAGE
#undef PG8_LDA
#undef PG8_LDB
#undef PG8_MMA
#undef PG8_WAIT_V
#undef PG8_WAIT_L
#undef PG8_BAR
#undef PG8_SCHED
}
}
typedef unsigned short bf16_t;
typedef short bf16x8 __attribute__((ext_vector_type(8)));
typedef short s16x4 __attribute__((ext_vector_type(4)));
typedef float f32x4 __attribute__((ext_vector_type(4)));
typedef float f32x16 __attribute__((ext_vector_type(16)));
typedef unsigned u32x4 __attribute__((ext_vector_type(4)));
typedef unsigned u32x2 __attribute__((ext_vector_type(2)));
typedef float f32x2_t __attribute__((ext_vector_type(2)));
typedef __bf16 bf16x2_t __attribute__((ext_vector_type(2)));

constexpr int NB = 8, SEQ = 4096, TOK = NB * SEQ, DM = 1024, NIN = 3072, INC = 2956, FF = 2816, NGU = 5632, DEPTH = 2;
constexpr int C_SBQ = 0, C_SBK = 256, C_SBV = 512, C_DFQ = 768, C_DFK = 1024, C_DFV = 1280, C_MBQ = 1536, C_MBK = 1792, C_MBV = 2048,
              C_NSQ = 2304, C_KC = 2560, C_VC = 2624, C_KS = 2688, C_VS = 2752, C_KW = 2816, C_VW = 2880, C_NSG = 2944;
constexpr size_t MiB = 1u << 20;
constexpr size_t WS_KMEAN = 71 * MiB, WS_KC = 262144, WS_VC = 524288, WS_CWT = 1 * MiB, WS_W = 2 * MiB;
constexpr size_t WL_IN = 0, WL_G = 6 * MiB, WL_B = 14 * MiB, WL_O = 16 * MiB, WL_GU = 18 * MiB, WL_D = 29 * MiB, WL_STRIDE = 34 * MiB + 512 * 1024;
constexpr size_t WS_XN = 72 * MiB, WS_O = 136 * MiB, WS_H = 200 * MiB, WS_X1 = 200 * MiB, WS_T = 200 * MiB, WS_A = 328 * MiB, WS_END = 504 * MiB;
constexpr int LDS_BYTES = 147456;
constexpr int NWAVES = 8;
constexpr float RMS_EPS = 1e-6f;

DI unsigned cvtpk(float lo, float hi) { f32x2_t v = {lo, hi}; bf16x2_t b = __builtin_convertvector(v, bf16x2_t); return __builtin_bit_cast(unsigned, b); }
DI float bf2f(unsigned short u) { return __builtin_bit_cast(float, (unsigned)u << 16); }
DI float bflo(unsigned u) { return __builtin_bit_cast(float, u << 16); }
DI float bfhi(unsigned u) { return __builtin_bit_cast(float, u & 0xffff0000u); }
DI float sigmoidf_(float x) { return __builtin_amdgcn_rcpf(1.0f + __builtin_amdgcn_exp2f(x * -1.4426950408889634f)); }


DI float shx(float v, int m, int lane) { return __builtin_bit_cast(float, __builtin_amdgcn_ds_bpermute((lane ^ m) << 2, __builtin_bit_cast(int, v))); }
DI unsigned shxu(unsigned v, int m, int lane) { return (unsigned)__builtin_amdgcn_ds_bpermute((lane ^ m) << 2, (int)v); }
DI float shx32(float v, int lane) {
    const unsigned u = __builtin_bit_cast(unsigned, v); auto rr = __builtin_amdgcn_permlane32_swap(u, u, false, false);
    return __builtin_bit_cast(float, (lane & 32) ? rr[0] : rr[1]); }

namespace pg8 {
struct EpiStore {
    static constexpr bool PERM = true, AFTER_DRAIN = false;
    bf16_t* O; int ldc;
    DI void operator()(const f32x4 (&acc)[2][2][4][2], const Unit& u, int wr, int wc, int fr, int fq) const {
        const int row0 = u.pm * BM + wr * 64 + fr, col0 = u.pn * BM + wc * 32 + 8 * fq;
#pragma unroll
        for (int ai = 0; ai < 2; ++ai)
#pragma unroll
            for (int m = 0; m < 4; ++m) { bf16_t* rowp = O + (size_t)(row0 + ai * HALF + m * 16) * ldc + col0;
#pragma unroll
                for (int bj = 0; bj < 2; ++bj) { const f32x4 v0 = acc[ai][bj][m][0], v1 = acc[ai][bj][m][1];
                    u32x4 w; w.x = cvtpk(v0[0], v0[1]); w.y = cvtpk(v0[2], v0[3]); w.z = cvtpk(v1[0], v1[1]); w.w = cvtpk(v1[2], v1[3]);
                    *(u32x4*)(rowp + bj * HALF) = w; } }
    }
};
struct EpiT {
    static constexpr bool PERM = true, AFTER_DRAIN = false;
    bf16_t* O;
    DI void operator()(const f32x4 (&acc)[2][2][4][2], const Unit& u, int wr, int wc, int fr, int fq) const {
        const int br = u.pn >> 2;
        const int row0 = (u.pm - 128 * br) * BM + wr * 64 + fr, col0 = br * 1024 + (u.pn & 3) * BM + wc * 32 + 8 * fq;
#pragma unroll
        for (int ai = 0; ai < 2; ++ai)
#pragma unroll
            for (int m = 0; m < 4; ++m) { bf16_t* rowp = O + (size_t)(row0 + ai * HALF + m * 16) * 4096 + col0;
#pragma unroll
                for (int bj = 0; bj < 2; ++bj) { const f32x4 v0 = acc[ai][bj][m][0], v1 = acc[ai][bj][m][1];
                    u32x4 w; w.x = cvtpk(v0[0], v0[1]); w.y = cvtpk(v0[2], v0[3]); w.z = cvtpk(v1[0], v1[1]); w.w = cvtpk(v1[2], v1[3]);
                    *(u32x4*)(rowp + bj * HALF) = w; } }
    }
};
struct DiagOrder {
    int G, c;
    DI bool next(int i, Unit& u) const {
        const int L = i * G + c; if (L >= 2048) return false;
        const int br = L >> 9, rem = L & 511; u.pm = br * 128 + (rem >> 2); u.pn = br * 4 + (rem & 3); return true;
    }
    DI void a_ready(const Unit&) const {}
    DI void done(const Unit&) const {}
};
struct EpiMerge {
    static constexpr bool PERM = false, AFTER_DRAIN = false;
    const bf16_t* T; const float* bg; bf16_t* O;
    DI void operator()(const f32x4 (&acc)[2][2][4][2], const Unit& u, int wr, int wc, int fr, int fq) const {
        const int row0 = u.pm * BM + wr * 64 + fr, mc0 = u.pn * 64 + wc * 16 + 4 * fq;
        f32x4 bv[4];
#pragma unroll
        for (int i = 0; i < 4; ++i) bv[i] = *(const f32x4*)(bg + i * 1024 + mc0);
#pragma unroll
        for (int ai = 0; ai < 2; ++ai)
#pragma unroll
            for (int m = 0; m < 4; ++m) { const int row = row0 + ai * HALF + m * 16; const bf16_t* tp = T + (size_t)row * 4096 + mc0;
                f32x4 r = {0.f, 0.f, 0.f, 0.f};
#pragma unroll
                for (int i = 0; i < 4; ++i) { const u32x2 tv = *(const u32x2*)(tp + i * 1024); const f32x4 a = acc[ai][i >> 1][m][i & 1] + bv[i];
                    r[0] += sigmoidf_(a[0]) * bflo(tv.x); r[1] += sigmoidf_(a[1]) * bfhi(tv.x); r[2] += sigmoidf_(a[2]) * bflo(tv.y); r[3] += sigmoidf_(a[3]) * bfhi(tv.y); }
                u32x2 w; w.x = cvtpk(r[0], r[1]); w.y = cvtpk(r[2], r[3]);
                *(u32x2*)(O + (size_t)row * 1024 + mc0) = w; }
    }
};
struct EpiResid {
    static constexpr bool PERM = true, AFTER_DRAIN = false;
    const float* base; float* out;
    DI void operator()(const f32x4 (&acc)[2][2][4][2], const Unit& u, int wr, int wc, int fr, int fq) const {
        const int row0 = u.pm * BM + wr * 64 + fr, col0 = u.pn * BM + wc * 32 + 8 * fq;
#pragma unroll
        for (int ai = 0; ai < 2; ++ai)
#pragma unroll
            for (int m = 0; m < 4; ++m) { const size_t off = (size_t)(row0 + ai * HALF + m * 16) * 1024 + col0;
#pragma unroll
                for (int bj = 0; bj < 2; ++bj) {
                    const f32x4 b0 = *(const f32x4*)(base + off + bj * HALF), b1 = *(const f32x4*)(base + off + bj * HALF + 4);
                    *(f32x4*)(out + off + bj * HALF) = b0 + acc[ai][bj][m][0]; *(f32x4*)(out + off + bj * HALF + 4) = b1 + acc[ai][bj][m][1]; } }
    }
};
struct EpiSwiGLU {
    static constexpr bool PERM = true, AFTER_DRAIN = false;
    bf16_t* O;
    DI void operator()(const f32x4 (&acc)[2][2][4][2], const Unit& u, int wr, int wc, int fr, int fq) const {
        const int row0 = u.pm * BM + wr * 64 + fr, col0 = u.pn * 128 + wc * 32 + 8 * fq;
#pragma unroll
        for (int ai = 0; ai < 2; ++ai)
#pragma unroll
            for (int m = 0; m < 4; ++m) { bf16_t* rowp = O + (size_t)(row0 + ai * HALF + m * 16) * FF + col0;
                float r[8];
#pragma unroll
                for (int n = 0; n < 2; ++n)
#pragma unroll
                    for (int e = 0; e < 4; ++e) { const float g = acc[ai][0][m][n][e], up = acc[ai][1][m][n][e]; r[4 * n + e] = g * sigmoidf_(g) * up; }
                u32x4 w; w.x = cvtpk(r[0], r[1]); w.y = cvtpk(r[2], r[3]); w.z = cvtpk(r[4], r[5]); w.w = cvtpk(r[6], r[7]);
                *(u32x4*)rowp = w; }
    }
};
}
#define RLX_AGENT __ATOMIC_RELAXED, __HIP_MEMORY_SCOPE_AGENT
#define XB_TMO      128
#define XB_XCNT(j)  (256  + 64 * (j))
#define XB_XSUB(j)  (1280 + 64 * (j))
#define XB_XGEN(j)  (2304 + 64 * (j))
#define XB_TOP      3328
#define XB_TOPGEN   3392
#define XCD_BAR_WORDS 3456
#define XB_SPIN_CAP (1u << 18)

__device__ __forceinline__ unsigned xb_ld(unsigned* p)              { return __hip_atomic_load(p, __ATOMIC_RELAXED, __HIP_MEMORY_SCOPE_AGENT); }
__device__ __forceinline__ unsigned xb_add(unsigned* p, unsigned v) { return __hip_atomic_fetch_add(p, v, __ATOMIC_RELAXED, __HIP_MEMORY_SCOPE_AGENT); }
__device__ __forceinline__ unsigned xb_xcc_id() { return (unsigned)__builtin_amdgcn_s_getreg((3 << 11) | 20) & 0xFu; }
#define XB_SPIN(cond, bar) do { unsigned _sp = 0; while (cond) { __builtin_amdgcn_s_sleep(1); \
    if ((++_sp & 255u) == 0u) { if (xb_ld(&(bar)[XB_TMO])) break; if (_sp > XB_SPIN_CAP) { atomicAdd(&(bar)[XB_TMO], 1u); break; } } } } while (0)

struct XcdBarrier {
    unsigned* bar; unsigned x;
    volatile LAS unsigned* st;
};

__device__ __forceinline__ XcdBarrier xcd_barrier_post(unsigned* bar, volatile LAS unsigned* st) {
    XcdBarrier b; b.bar = bar; b.x = xb_xcc_id(); b.st = st;
    if (threadIdx.x == 0) (void)xb_add(&bar[XB_XCNT(b.x)], 1u);
    return b;
}
__device__ __forceinline__ void xcd_barrier_complete(unsigned* bar, unsigned x, unsigned& nloc, unsigned& nx) {
    const unsigned G = gridDim.x * gridDim.y * gridDim.z;
    unsigned sum, cnt, mine, sp = 0u;
    for (;;) {
        sum = 0u; cnt = 0u; mine = 0u;
#pragma unroll
        for (unsigned j = 0; j < 16; ++j) { const unsigned c = xb_ld(&bar[XB_XCNT(j)]); sum += c; cnt += (c > 0u) ? 1u : 0u; mine = (j == x) ? c : mine; }
        if (sum == G) break;
        __builtin_amdgcn_s_sleep(1);
        if ((++sp & 255u) == 0u) { if (xb_ld(&bar[XB_TMO])) break; if (sp > XB_SPIN_CAP) { atomicAdd(&bar[XB_TMO], 1u); break; } }
    }
    nloc = mine > 0u ? mine : 1u; nx = cnt > 0u ? cnt : 1u;
}

__device__ __forceinline__ void xcd_barrier(const XcdBarrier& b, const int wave_s) {
    asm volatile("s_waitcnt vmcnt(0)" ::: "memory");
    __syncthreads();
    if (wave_s == 0 && fresh_lane() == 0) {
        unsigned* bar = b.bar;
        __builtin_amdgcn_s_waitcnt(0);
        unsigned nloc = b.st[0], nx = b.st[1];
        if (nloc == 0u) { xcd_barrier_complete(bar, b.x, nloc, nx); b.st[0] = nloc; b.st[1] = nx; }
        const unsigned old = xb_add(&bar[XB_XSUB(b.x)], 1u);
        const unsigned gen = old / nloc;
        if (old + 1u == (gen + 1u) * nloc) {
            __builtin_amdgcn_fence(__ATOMIC_RELEASE, "agent");
            asm volatile("s_waitcnt vmcnt(0)" ::: "memory");
            const unsigned og = xb_add(&bar[XB_TOP], 1u);
            const unsigned tg = og / nx;
            if (og + 1u == (tg + 1u) * nx) xb_add(&bar[XB_TOPGEN], 1u);
            else XB_SPIN(xb_ld(&bar[XB_TOPGEN]) == tg, bar);
            __builtin_amdgcn_fence(__ATOMIC_ACQUIRE, "agent");
            xb_add(&bar[XB_XGEN(b.x)], 1u);
            asm volatile("s_waitcnt vmcnt(0)" ::: "memory");
        } else {
            XB_SPIN(xb_ld(&bar[XB_XGEN(b.x)]) == gen, bar);
            __builtin_amdgcn_fence(__ATOMIC_ACQUIRE, "agent");
            asm volatile("s_waitcnt vmcnt(0)" ::: "memory");
        }
    }
    __syncthreads();
}
struct Params { const float* in[21]; float* out; unsigned char* ws; };

DI float wave_sum(float v, int lane) {
#pragma unroll
    for (int o = 1; o < 32; o <<= 1) v += shx(v, o, lane);
    return v + shx32(v, lane);
}
#define LDS_WAIT() asm volatile("s_waitcnt lgkmcnt(0)" ::: "memory")

DI int rowmap(int mode, int arg, int n) {
    if (mode == 1) { const int pn = n >> 6, w = n & 63; return 256 * pn + 128 * (arg >> 1) + 32 * (w >> 4) + 16 * (arg & 1) + (w & 15); }
    if (mode == 2) { return 256 * (n >> 7) + 128 * arg + (n & 127); }
    return n;
}
struct TJob { const float* W; bf16_t* WT; int K, Nsrc, nblk, mode, arg; };
DI TJob get_job(const Params& P, int l, int j) {
    TJob t; unsigned char* wl = P.ws + WS_W + (size_t)l * WL_STRIDE; t.mode = 0; t.arg = 0;
    if (j == 0) { t.W = P.in[2] + (size_t)l * 1024 * INC; t.WT = (bf16_t*)(wl + WL_IN); t.K = 1024; t.Nsrc = INC; t.nblk = NIN / 32; }
    else if (j < 5) { const int i = j - 1; t.W = P.in[13] + (size_t)(l * 4 + i) * 1024 * 1024; t.WT = (bf16_t*)(wl + WL_G); t.K = 1024; t.Nsrc = 1024; t.nblk = 32; t.mode = 1; t.arg = i; }
    else if (j < 9) { const int i = j - 5; t.W = P.in[15] + (size_t)(l * 4 + i) * 256 * 1024; t.WT = (bf16_t*)(wl + WL_B) + (size_t)i * 1024 * 256; t.K = 256; t.Nsrc = 1024; t.nblk = 32; }
    else if (j == 9) { t.W = P.in[16] + (size_t)l * 1024 * 1024; t.WT = (bf16_t*)(wl + WL_O); t.K = 1024; t.Nsrc = 1024; t.nblk = 32; }
    else if (j < 12) { const int i = j - 10; t.W = P.in[18 + i] + (size_t)l * 1024 * FF; t.WT = (bf16_t*)(wl + WL_GU); t.K = 1024; t.Nsrc = FF; t.nblk = FF / 32; t.mode = 2; t.arg = i; }
    else if (j == 12) { t.W = P.in[20] + (size_t)l * FF * 1024; t.WT = (bf16_t*)(wl + WL_D); t.K = FF; t.Nsrc = 1024; t.nblk = 32; }
    else { const int kv = j - 13; t.W = P.in[12] + (size_t)(l * 2 + kv) * 2048 * 64; t.WT = (bf16_t*)(P.ws + WS_CWT) + (size_t)(l * 2 + kv) * 64 * 2048; t.K = 2048; t.Nsrc = 64; t.nblk = 2; }
    return t;
}
DI void transpose_item(const TJob& t, LAS float* scr, int item, int lane) {
    const int kb = item / t.nblk, nb = item % t.nblk, k0 = 64 * kb, n0 = 32 * nb;
    const int nn = n0 + (lane & 31);
#pragma unroll
    for (int i = 0; i < 32; ++i) { const int kk = 2 * i + (lane >> 5); scr[kk * 33 + (lane & 31)] = (nn < t.Nsrc) ? t.W[(size_t)(k0 + kk) * t.Nsrc + nn] : 0.f; }
    LDS_WAIT(); asm volatile("" ::: "memory");
    const int c = lane & 7;
#pragma unroll
    for (int j = 0; j < 4; ++j) { const int n = (lane >> 3) + 8 * j; const LAS float* s = scr + (8 * c) * 33 + n;
        u32x4 o; o.x = cvtpk(s[0 * 33], s[1 * 33]); o.y = cvtpk(s[2 * 33], s[3 * 33]); o.z = cvtpk(s[4 * 33], s[5 * 33]); o.w = cvtpk(s[6 * 33], s[7 * 33]);
        const int row = rowmap(t.mode, t.arg, n0 + n);
        *(u32x4*)(t.WT + (size_t)row * t.K + k0 + 8 * c) = o; }
    LDS_WAIT(); asm volatile("" ::: "memory");
}
DI void prologue_phase(const Params& P, LAS unsigned char* lds, int gw, int NGW, int wave, int lane) {
    LAS float* scr = (LAS float*)(lds + wave * 16384);
    for (int gi = gw; gi < 2 * 8960; gi += NGW) {
        const int l = gi >= 8960 ? 1 : 0; int r = gi - l * 8960, j, it;
        if (r < 1536) { j = 0; it = r; }
        else if ((r -= 1536) < 2048) { j = 1 + (r >> 9); it = r & 511; }
        else if ((r -= 2048) < 512) { j = 5 + (r >> 7); it = r & 127; }
        else if ((r -= 512) < 512) { j = 9; it = r; }
        else if ((r -= 512) < 2816) { j = 10 + (r >= 1408 ? 1 : 0); it = r >= 1408 ? r - 1408 : r; }
        else if ((r -= 2816) < 1408) { j = 12; it = r; }
        else { r -= 1408; j = 13 + (r >> 6); it = r & 63; }
        const TJob t = get_job(P, l, j);
        transpose_item(t, scr, it, lane);
    }
}

DI void rms_phase(const float* x, const float* g, bf16_t* out, int gw, int NGW, int lane) {
    f32x4 gv[4];
#pragma unroll
    for (int j = 0; j < 4; ++j) gv[j] = ((const f32x4*)g)[lane + 64 * j];
    for (int m = gw; m < TOK; m += 2 * NGW) {
        const int m2 = m + NGW; const bool has2 = m2 < TOK;
        const f32x4* xa = (const f32x4*)(x + (size_t)m * DM) + lane; const f32x4* xb = (const f32x4*)(x + (size_t)(has2 ? m2 : m) * DM) + lane;
        f32x4 va[4], vb[4]; float sa = 0.f, sb = 0.f;
#pragma unroll
        for (int j = 0; j < 4; ++j) { va[j] = xa[64 * j]; vb[j] = xb[64 * j]; }
#pragma unroll
        for (int j = 0; j < 4; ++j) { sa += (va[j].x * va[j].x + va[j].y * va[j].y) + (va[j].z * va[j].z + va[j].w * va[j].w);
                                      sb += (vb[j].x * vb[j].x + vb[j].y * vb[j].y) + (vb[j].z * vb[j].z + vb[j].w * vb[j].w); }
        const float ra = 1.0f / sqrtf(wave_sum(sa, lane) * (1.0f / DM) + RMS_EPS), rb = 1.0f / sqrtf(wave_sum(sb, lane) * (1.0f / DM) + RMS_EPS);
        unsigned long long* oa = (unsigned long long*)(out + (size_t)m * DM) + lane;
#pragma unroll
        for (int j = 0; j < 4; ++j) { const f32x4 y = va[j] * ra * gv[j]; oa[64 * j] = (unsigned long long)cvtpk(y.x, y.y) | ((unsigned long long)cvtpk(y.z, y.w) << 32); }
        if (has2) { unsigned long long* ob = (unsigned long long*)(out + (size_t)m2 * DM) + lane;
#pragma unroll
            for (int j = 0; j < 4; ++j) { const f32x4 y = vb[j] * rb * gv[j]; ob[64 * j] = (unsigned long long)cvtpk(y.x, y.y) | ((unsigned long long)cvtpk(y.z, y.w) << 32); } }
    }
}

DI void rope_cs(float pos, float inv, float& c, float& s) {
    const float ang = pos * inv; double rev = (double)ang * 0.15915494309189535; rev -= __builtin_rint(rev);
    const float r = (float)rev; s = __builtin_amdgcn_sinf(r); c = __builtin_amdgcn_cosf(r);
}
constexpr float LOG2_THETA = 18.931568569324174f;
DI void unpack8(const u32x4 w, float (&v)[8]) { v[0] = bflo(w.x); v[1] = bfhi(w.x); v[2] = bflo(w.y); v[3] = bfhi(w.y); v[4] = bflo(w.z); v[5] = bfhi(w.z); v[6] = bflo(w.w); v[7] = bfhi(w.w); }

constexpr float LOG2E_ = 1.4426950408889634f;
DI void prep_norm_item(const Params& P, int l, int it, int lane) {
    bf16_t* hb = (bf16_t*)(P.ws + WS_H);
    const int blk = it / 10, sp10 = it % 10, sp = sp10 < 4 ? 4 + sp10 : (sp10 < 8 ? 8 + sp10 : 12 + sp10), sub = lane & 7, tl = lane >> 3;
    int col; const float* g; bool diff = false, km = false; float qs = 1.0f;
    if (sp < 4) { col = C_DFQ + 64 * sp; g = P.in[3] + l * 32; diff = true; qs = 0.17677669529663687f * LOG2E_; }
    else if (sp < 8) { col = C_DFK + 64 * (sp - 4); g = P.in[4] + l * 32; diff = true; }
    else if (sp < 12) { col = C_MBQ + 64 * (sp - 8); g = P.in[7] + l * 64; qs = 0.125f * LOG2E_; }
    else if (sp < 16) { col = C_MBK + 64 * (sp - 12); g = P.in[8] + l * 64; km = true; }
    else if (sp < 20) { col = C_NSQ + 64 * (sp - 16); g = P.in[9] + l * 64; qs = 0.125f * LOG2E_; }
    else if (sp == 20) { col = C_KS; g = P.in[10] + (l * 3 + 1) * 64; }
    else { col = C_KW; g = P.in[10] + (l * 3 + 2) * 64; }
    float gv[8], inv[8], kacc[8];
#pragma unroll
    for (int e = 0; e < 8; ++e) { gv[e] = (diff ? g[8 * (sub & 3) + e] : g[8 * sub + e]); kacc[e] = 0.f;
        inv[e] = diff ? exp2f(-(float)(e & 3) * 0.25f * LOG2_THETA) : exp2f(-(float)e * 0.125f * LOG2_THETA); }
    u32x4* p0 = (u32x4*)(hb + (size_t)(blk * 64 + tl) * NIN + col + 8 * sub);
    u32x4 raw[8];
#pragma unroll
    for (int i = 0; i < 8; ++i) raw[i] = p0[(size_t)i * 8 * NIN / 8];
#pragma unroll
    for (int i = 0; i < 8; ++i) {
        const int tok = blk * 64 + 8 * i + tl; const float pos = (float)(tok & (SEQ - 1));
        float v[8]; unpack8(raw[i], v);
        float ss = 0.f;
#pragma unroll
        for (int e = 0; e < 8; ++e) ss += v[e] * v[e];
        ss += shx(ss, 1, lane); ss += shx(ss, 2, lane);
        if (!diff) ss += shx(ss, 4, lane);
        const float rstd = 1.0f / sqrtf(ss * (diff ? (1.0f / 32.0f) : (1.0f / 64.0f)) + RMS_EPS);
#pragma unroll
        for (int e = 0; e < 8; ++e) v[e] = v[e] * rstd * gv[e];
        if (diff) {
            if ((sub & 3) == 0) {
#pragma unroll
                for (int e = 0; e < 4; ++e) { float c, s; rope_cs(pos, inv[e], c, s); const float a = v[e], b = v[e + 4]; v[e] = a * c - b * s; v[e + 4] = b * c + a * s; }
            }
        } else {
            float pr[8];
#pragma unroll
            for (int e = 0; e < 8; ++e) pr[e] = shx(v[e], 1, lane);
            if (sub < 2) {
#pragma unroll
                for (int e = 0; e < 8; ++e) { float c, s; rope_cs(pos, inv[e], c, s); v[e] = (sub == 0) ? (v[e] * c - pr[e] * s) : (v[e] * c + pr[e] * s); }
            }
        }
#pragma unroll
        for (int e = 0; e < 8; ++e) kacc[e] += v[e];
        u32x4 w; w.x = cvtpk(v[0] * qs, v[1] * qs); w.y = cvtpk(v[2] * qs, v[3] * qs); w.z = cvtpk(v[4] * qs, v[5] * qs); w.w = cvtpk(v[6] * qs, v[7] * qs);
        p0[(size_t)i * 8 * NIN / 8] = w;
    }
    if (km) {
#pragma unroll
        for (int e = 0; e < 8; ++e) { float a = kacc[e]; a += shx(a, 8, lane); a += shx(a, 16, lane); a += shx32(a, lane); kacc[e] = a; }
        if (tl == 0) { float* kmp = (float*)(P.ws + WS_KMEAN) + ((((size_t)((blk >> 6) * 4 + (sp - 12)) * 16 + ((blk >> 2) & 15)) * 4 + (blk & 3)) * 64) + 8 * sub;
            *(f32x4*)kmp = (f32x4){kacc[0], kacc[1], kacc[2], kacc[3]}; *(f32x4*)(kmp + 4) = (f32x4){kacc[4], kacc[5], kacc[6], kacc[7]}; }
    }
}
#define MFMA32(a, b, c) __builtin_amdgcn_mfma_f32_32x32x16_bf16((a), (b), (c), 0, 0, 0)
DI void prep_compress_item(const Params& P, int l, int it, LAS unsigned char* lds, int wave, int lane) {
    const bf16_t* hb = (const bf16_t*)(P.ws + WS_H);
    const int kv = it & 1, nt = (it >> 1) & 7, b = it >> 4, r = lane & 31, h = lane >> 5;
    const bf16_t* cw = (const bf16_t*)(P.ws + WS_CWT) + (size_t)(l * 2 + kv) * 64 * 2048;
    const float* pe = P.in[11] + (size_t)(l * 2 + kv) * 32 * 64;
    const int col = kv ? C_VC : C_KC, n = 32 * nt + r;
    f32x16 acc[2];
#pragma unroll
    for (int i = 0; i < 16; ++i) { acc[0][i] = 0.f; acc[1][i] = 0.f; }
#pragma unroll
    for (int jj = 0; jj < 4; ++jj) {
        const int j = 4 * wave + jj;
        int tok = 16 * n + j; tok = tok > SEQ - 1 ? SEQ - 1 : tok;
        const bf16_t* xp = hb + (size_t)(b * SEQ + tok) * NIN + col + 8 * h;
#pragma unroll
        for (int ds = 0; ds < 4; ++ds) {
            float v[8]; unpack8(*(const u32x4*)(xp + 16 * ds), v);
            const f32x4 p0 = *(const f32x4*)(pe + j * 64 + 16 * ds + 8 * h), p1 = *(const f32x4*)(pe + j * 64 + 16 * ds + 8 * h + 4);
            u32x4 w; w.x = cvtpk(v[0] + p0[0], v[1] + p0[1]); w.y = cvtpk(v[2] + p0[2], v[3] + p0[3]); w.z = cvtpk(v[4] + p1[0], v[5] + p1[1]); w.w = cvtpk(v[6] + p1[2], v[7] + p1[3]);
            const bf16x8 bfrag = __builtin_bit_cast(bf16x8, w);
            const int k0 = j * 64 + 16 * ds + 8 * h;
            const bf16x8 a0 = *(const bf16x8*)(cw + (size_t)r * 2048 + k0), a1 = *(const bf16x8*)(cw + (size_t)(32 + r) * 2048 + k0);
            acc[0] = MFMA32(a0, bfrag, acc[0]); acc[1] = MFMA32(a1, bfrag, acc[1]);
        }
    }
    LAS float* part = (LAS float*)lds;
#pragma unroll
    for (int et = 0; et < 2; ++et)
#pragma unroll
        for (int i = 0; i < 16; ++i) part[(wave * 32 + et * 16 + i) * 64 + lane] = acc[et][i];
    __syncthreads();
    if (wave == 0) {
#pragma unroll
        for (int et = 0; et < 2; ++et)
#pragma unroll
            for (int i = 0; i < 16; ++i) { float a = acc[et][i];
#pragma unroll
                for (int w = 1; w < 8; ++w) a += part[(w * 32 + et * 16 + i) * 64 + lane];
                acc[et][i] = a; }
        if (kv == 0) {
            const float* g = P.in[10] + (size_t)(l * 3 + 0) * 64;
            float ss = 0.f;
#pragma unroll
            for (int i = 0; i < 16; ++i) ss += acc[0][i] * acc[0][i] + acc[1][i] * acc[1][i];
            ss += shx32(ss, lane);
            const float rstd = 1.0f / sqrtf(ss * (1.0f / 64.0f) + RMS_EPS);
#pragma unroll
            for (int et = 0; et < 2; ++et)
#pragma unroll
                for (int i = 0; i < 16; ++i) { const int e = 32 * et + (i & 3) + 8 * (i >> 2) + 4 * h; acc[et][i] = acc[et][i] * rstd * g[e]; }
            const float pos = (float)(16 * n + 31);
#pragma unroll
            for (int i = 0; i < 4; ++i) { const int e = 4 * h + i; float c, s; rope_cs(pos, exp2f(-(float)e * 0.125f * LOG2_THETA), c, s);
                const float a = acc[0][i], bq = acc[0][i + 4]; acc[0][i] = a * c - bq * s; acc[0][i + 4] = bq * c + a * s; }
        }
        bf16_t* dst = (bf16_t*)(P.ws + (kv ? WS_VC : WS_KC)) + (size_t)(b * 256 + n) * 64;
#pragma unroll
        for (int et = 0; et < 2; ++et)
#pragma unroll
            for (int gq = 0; gq < 4; ++gq) { u32x2 w; w.x = cvtpk(acc[et][4 * gq], acc[et][4 * gq + 1]); w.y = cvtpk(acc[et][4 * gq + 2], acc[et][4 * gq + 3]);
                *(u32x2*)(dst + 32 * et + 8 * gq + 4 * h) = w; }
    }
    __syncthreads();
}
DI void prep_phase(const Params& P, int l, LAS unsigned char* lds, int G, int bx, int gw, int NGW, int wave, int lane) {
    for (int it = bx; it < 128; it += G) prep_compress_item(P, l, it, lds, wave, lane);
    if (G == 256) {
        prep_norm_item(P, l, gw, lane); prep_norm_item(P, l, gw + NGW, lane);
        if (bx >= 128) prep_norm_item(P, l, 4096 + (bx - 128) * 8 + wave, lane);
    } else {
        for (int it = gw; it < 512 * 10; it += NGW) prep_norm_item(P, l, it, lane);
    }
}
typedef short v4i16_t __attribute__((ext_vector_type(4)));
constexpr int KP = 144;
constexpr int TILE_B = 64 * KP;
constexpr float LOG2E = 1.4426950408889634f;
enum { MODE_DIFF = 0, MODE_MOBA = 1, MODE_NSEL = 2, MODE_NWIN = 3 };

DI s16x4 vtr(LAS const char* p) { return __builtin_bit_cast(s16x4, __builtin_amdgcn_ds_read_tr16_b64_v4i16((LAS v4i16_t*)p)); }
DI float ex2(float x) { return __builtin_amdgcn_exp2f(x); }

template <int KS0, int KS1> DI f32x16 qk_rows(LAS const char* Kl, int row0, const bf16x8 (&qf)[4], int r, int h) {
    f32x16 s;
#pragma unroll
    for (int i = 0; i < 16; ++i) s[i] = 0.f;
    LAS const char* p = Kl + (row0 + r) * KP + 16 * h;
    bf16x8 kf[4];
#pragma unroll
    for (int ks = KS0; ks < KS1; ++ks) kf[ks] = *(LAS const bf16x8*)(p + 32 * ks);
    __builtin_amdgcn_s_setprio(1);
#pragma unroll
    for (int ks = KS0; ks < KS1; ++ks) s = MFMA32(kf[ks], qf[ks], s);
    __builtin_amdgcn_s_setprio(0);
    return s;
}
DI void pv_rows(f32x16 (&o)[2], LAS const char* Vl, int row0, const bf16x8 (&pf)[2], int lane) {
    const int h = lane >> 5, i = lane & 15, grp = (lane >> 4) & 1;
    LAS const char* base = Vl + (row0 + 4 * h + (i >> 2)) * KP + grp * 32 + (i & 3) * 8;
    bf16x8 vf[2][2];
#pragma unroll
    for (int dt = 0; dt < 2; ++dt)
#pragma unroll
        for (int s2 = 0; s2 < 2; ++s2) {
            const s16x4 lo = vtr(base + (16 * s2) * KP + dt * 64), hi = vtr(base + (16 * s2 + 8) * KP + dt * 64);
            vf[dt][s2] = (bf16x8){lo[0], lo[1], lo[2], lo[3], hi[0], hi[1], hi[2], hi[3]};
        }
    __builtin_amdgcn_s_setprio(1);
#pragma unroll
    for (int s2 = 0; s2 < 2; ++s2)
#pragma unroll
        for (int dt = 0; dt < 2; ++dt) o[dt] = MFMA32(vf[dt][s2], pf[s2], o[dt]);
    __builtin_amdgcn_s_setprio(0);
}
DI void pack_p(const float (&p)[16], bf16x8 (&pf)[2]) {
#pragma unroll
    for (int s2 = 0; s2 < 2; ++s2) { u32x4 w; w.x = cvtpk(p[8 * s2], p[8 * s2 + 1]); w.y = cvtpk(p[8 * s2 + 2], p[8 * s2 + 3]); w.z = cvtpk(p[8 * s2 + 4], p[8 * s2 + 5]); w.w = cvtpk(p[8 * s2 + 6], p[8 * s2 + 7]);
        pf[s2] = __builtin_bit_cast(bf16x8, w); }
}
template <int MM> DI void smax_step(const f32x16& s, unsigned vm, float& m, float& l, f32x16 (&o)[2], bf16x8 (&pf)[2], int lane) {
    float t[16], mx = -1e30f;
#pragma unroll
    for (int i = 0; i < 16; ++i) { t[i] = (MM == 0) ? s[i] : (MM == 1 ? (vm ? s[i] : -1e30f) : (((vm >> i) & 1u) ? s[i] : -1e30f)); mx = fmaxf(mx, t[i]); }
    mx = fmaxf(mx, shx32(mx, lane));
    const float mn = (mx > m + 8.0f) ? mx : m;
    const float mref = fmaxf(mn, -1e29f);
    float p[16], rs = 0.f;
#pragma unroll
    for (int i = 0; i < 16; ++i) { p[i] = ex2(t[i] - mref); rs += p[i]; }
    rs += shx32(rs, lane);
    if (__builtin_amdgcn_ballot_w64(mn != m) != 0ull) {
        const float alpha = ex2(m - mn);
        l *= alpha;
#pragma unroll
        for (int i = 0; i < 16; ++i) { o[0][i] *= alpha; o[1][i] *= alpha; }
        m = mn;
    }
    l += rs;
    pack_p(p, pf);
}
template <int MM> DI void smax_step64(const f32x16& sa, const f32x16& sb, unsigned vm, float& m, float& l, f32x16 (&o)[2], bf16x8 (&pf)[4], int lane) {
    float mx = -1e30f;
#pragma unroll
    for (int i = 0; i < 16; ++i) mx = fmaxf(mx, fmaxf(sa[i], sb[i]));
    if (MM == 1) mx = vm ? mx : -1e30f;
    mx = fmaxf(mx, shx32(mx, lane));
    const float mn = (mx > m + 8.0f) ? mx : m;
    float mref = fmaxf(mn, -1e29f);
    if (MM == 1) mref = vm ? mref : 3e38f;
    float rs = 0.f;
    {   float pa[16]; bf16x8 t2[2];
#pragma unroll
        for (int i = 0; i < 16; ++i) { pa[i] = ex2(sa[i] - mref); rs += pa[i]; }
        pack_p(pa, t2); pf[0] = t2[0]; pf[1] = t2[1]; }
    {   float pb[16]; bf16x8 t2[2];
#pragma unroll
        for (int i = 0; i < 16; ++i) { pb[i] = ex2(sb[i] - mref); rs += pb[i]; }
        pack_p(pb, t2); pf[2] = t2[0]; pf[3] = t2[1]; }
    rs += shx32(rs, lane);
    if (__builtin_amdgcn_ballot_w64(mn != m) != 0ull) {
        const float alpha = ex2(m - mn);
        l *= alpha;
#pragma unroll
        for (int i = 0; i < 16; ++i) { o[0][i] *= alpha; o[1][i] *= alpha; }
        m = mn;
    }
    l += rs;
}
DI void pv_rows64(f32x16 (&o)[2], LAS const char* Vl, const bf16x8 (&pf)[4], int lane) {
    const int h = lane >> 5, i = lane & 15, grp = (lane >> 4) & 1;
    LAS const char* base = Vl + (4 * h + (i >> 2)) * KP + grp * 32 + (i & 3) * 8;
#pragma unroll
    for (int s4 = 0; s4 < 4; ++s4)
#pragma unroll
        for (int dt = 0; dt < 2; ++dt) {
            const s16x4 lo = vtr(base + (16 * s4) * KP + dt * 64), hi = vtr(base + (16 * s4 + 8) * KP + dt * 64);
            const bf16x8 vf = {lo[0], lo[1], lo[2], lo[3], hi[0], hi[1], hi[2], hi[3]};
            o[dt] = MFMA32(vf, pf[s4], o[dt]);
        }
}
template <int MM> DI void smax_step_nb(const f32x16& s, unsigned vm, float& m, float& l, f32x16 (&o)[2], bf16x8 (&pf)[2], int lane) {
    float mx = -1e30f;
#pragma unroll
    for (int i = 0; i < 16; ++i) mx = fmaxf(mx, s[i]);
    if (MM == 1) mx = vm ? mx : -1e30f;
    mx = fmaxf(mx, shx32(mx, lane));
    const float mn = (mx > m + 8.0f) ? mx : m;
    float mref = fmaxf(mn, -1e29f);
    if (MM == 1) mref = vm ? mref : 3e38f;
    const float alpha = ex2(m - mn);
    float p[16], rs = 0.f;
#pragma unroll
    for (int i = 0; i < 16; ++i) { p[i] = ex2(s[i] - mref); rs += p[i]; }
    rs += shx32(rs, lane);
    l = l * alpha + rs;
    if (__builtin_amdgcn_ballot_w64(mn != m) != 0ull) {
#pragma unroll
        for (int i = 0; i < 16; ++i) { o[0][i] *= alpha; o[1][i] *= alpha; }
    }
    m = mn;
    pack_p(p, pf);
}
template <int MM> DI void tile64_pipe(LAS const char* Kl, LAS const char* Vl, const bf16x8 (&qf)[4], unsigned vm, float& m, float& l, f32x16 (&o)[2], int r, int h, int lane) {
    const f32x16 sa = qk_rows<0, 4>(Kl, 0, qf, r, h), sb = qk_rows<0, 4>(Kl, 32, qf, r, h);
    bf16x8 pfa[2], pfb[2];
    smax_step_nb<MM>(sa, vm, m, l, o, pfa, lane);
    pv_rows(o, Vl, 0, pfa, lane);
    smax_step_nb<MM>(sb, vm, m, l, o, pfb, lane);
    pv_rows(o, Vl, 32, pfb, lane);
}
template <int MM> DI void tile128_pipe(LAS const char* K0, LAS const char* V0, LAS const char* K1, LAS const char* V1, const bf16x8 (&qf)[4], unsigned vm0, unsigned vm1,
                                       float& m, float& l, f32x16 (&o)[2], int r, int h, int lane) {
    f32x16 sa = qk_rows<0, 4>(K0, 0, qf, r, h), sb = qk_rows<0, 4>(K0, 32, qf, r, h);
    bf16x8 pfa[2], pfb[2];
    smax_step_nb<MM>(sa, vm0, m, l, o, pfa, lane);
    sa = qk_rows<0, 4>(K1, 0, qf, r, h);
    pv_rows(o, V0, 0, pfa, lane);
    smax_step_nb<MM>(sb, vm0, m, l, o, pfb, lane);
    sb = qk_rows<0, 4>(K1, 32, qf, r, h);
    pv_rows(o, V0, 32, pfb, lane);
    smax_step_nb<MM>(sa, vm1, m, l, o, pfa, lane);
    pv_rows(o, V1, 0, pfa, lane);
    smax_step_nb<MM>(sb, vm1, m, l, o, pfb, lane);
    pv_rows(o, V1, 32, pfb, lane);
}
struct Stage { u32x4 k, v; };
DI void stage_load(Stage& st, const bf16_t* Kg, const bf16_t* Vg, int pitch, int key0, int tid) {
    const int key = tid >> 3, c = tid & 7;
    st.k = *(const u32x4*)(Kg + (size_t)(key0 + key) * pitch + 8 * c); st.v = *(const u32x4*)(Vg + (size_t)(key0 + key) * pitch + 8 * c);
}
DI void stage_store(const Stage& st, LAS char* Kl, LAS char* Vl, int tid) {
    const int key = tid >> 3, c = tid & 7;
    *(LAS u32x4*)(Kl + key * KP + 16 * c) = st.k; *(LAS u32x4*)(Vl + key * KP + 16 * c) = st.v;
}
DI void zero_o(f32x16 (&o)[2]) {
#pragma unroll
    for (int i = 0; i < 16; ++i) { o[0][i] = 0.f; o[1][i] = 0.f; }
}
DI void load_q(bf16x8 (&qf)[4], const bf16_t* qrow, int h) {
#pragma unroll
    for (int ks = 0; ks < 4; ++ks) qf[ks] = *(const bf16x8*)(qrow + 16 * ks + 8 * h);
}
DI void store_o(bf16_t* dst, const f32x16 (&o)[2], int h) {
#pragma unroll
    for (int dt = 0; dt < 2; ++dt)
#pragma unroll
        for (int g = 0; g < 4; ++g) { u32x2 w; w.x = cvtpk(o[dt][4 * g], o[dt][4 * g + 1]); w.y = cvtpk(o[dt][4 * g + 2], o[dt][4 * g + 3]);
            *(u32x2*)(dst + 32 * dt + 8 * g + 4 * h) = w; }
}

template <bool DIFFQ> DI void norm_rope_q(bf16x8 (&qf)[4], const float* g, float qs, int qpos, int h, int lane) {
    float qv[4][8];
#pragma unroll
    for (int ks = 0; ks < 4; ++ks) unpack8(__builtin_bit_cast(u32x4, qf[ks]), qv[ks]);
    float ssa = 0.f, ssb = 0.f;
#pragma unroll
    for (int j = 0; j < 8; ++j) { ssa += qv[0][j] * qv[0][j] + qv[1][j] * qv[1][j]; ssb += qv[2][j] * qv[2][j] + qv[3][j] * qv[3][j]; }
    ssa += shx32(ssa, lane); ssb += shx32(ssb, lane);
    float ra, rb;
    if (DIFFQ) { ra = 1.0f / sqrtf(ssa * (1.0f / 32.0f) + RMS_EPS); rb = 1.0f / sqrtf(ssb * (1.0f / 32.0f) + RMS_EPS); }
    else { ra = rb = 1.0f / sqrtf((ssa + ssb) * (1.0f / 64.0f) + RMS_EPS); }
#pragma unroll
    for (int ks = 0; ks < 4; ++ks)
#pragma unroll
        for (int j = 0; j < 8; ++j) { const int d = 16 * ks + 8 * h + j; qv[ks][j] = qv[ks][j] * (ks < 2 ? ra : rb) * g[DIFFQ ? (d & 31) : d]; }
    const float pos = (float)qpos;
    if (DIFFQ) {
        if (h == 0) {
#pragma unroll
            for (int mp = 0; mp < 2; ++mp)
#pragma unroll
                for (int e = 0; e < 4; ++e) { float c, sn; rope_cs(pos, exp2f(-(float)e * 0.25f * LOG2_THETA), c, sn);
                    const float a = qv[2 * mp][e], bq = qv[2 * mp][e + 4]; qv[2 * mp][e] = a * c - bq * sn; qv[2 * mp][e + 4] = bq * c + a * sn; }
        }
    } else {
        float pr[8];
#pragma unroll
        for (int j = 0; j < 8; ++j) pr[j] = shx32(qv[0][j], lane);
#pragma unroll
        for (int e = 0; e < 8; ++e) { float c, sn; rope_cs(pos, exp2f(-(float)e * 0.125f * LOG2_THETA), c, sn);
            qv[0][e] = (h == 0) ? (qv[0][e] * c - pr[e] * sn) : (qv[0][e] * c + pr[e] * sn); }
    }
#pragma unroll
    for (int ks = 0; ks < 4; ++ks) { u32x4 w; w.x = cvtpk(qv[ks][0] * qs, qv[ks][1] * qs); w.y = cvtpk(qv[ks][2] * qs, qv[ks][3] * qs); w.z = cvtpk(qv[ks][4] * qs, qv[ks][5] * qs); w.w = cvtpk(qv[ks][6] * qs, qv[ks][7] * qs);
        qf[ks] = __builtin_bit_cast(bf16x8, w); }
}
struct Stage2 { u32x4 k0, v0, k1, v1; };
DI void flash_prefetch(Stage2& st, const bf16_t* Kg, const bf16_t* Vg, int pitch, int kt_lo, int kt_hi, int tid) {
    const int skey = tid >> 3, sc = tid & 7, t1 = (kt_lo + 1 > kt_hi) ? kt_hi : kt_lo + 1;
    const size_t a0 = (size_t)(64 * kt_lo + skey) * pitch + 8 * sc, a1 = (size_t)(64 * t1 + skey) * pitch + 8 * sc;
    st.k0 = *(const u32x4*)(Kg + a0); st.v0 = *(const u32x4*)(Vg + a0); st.k1 = *(const u32x4*)(Kg + a1); st.v1 = *(const u32x4*)(Vg + a1);
}
template <int MODE, bool PRE = false>
DI void flash_tiles(LAS char* lds, const bf16_t* Kg, const bf16_t* Vg, int pitch, int kt_lo, int kt_hi,
                    const bf16x8 (&qf)[4], int qpos, int q0w, unsigned long long sel, float c,
                    float& m1, float& l1, f32x16 (&o1)[2], float& m2, float& l2, f32x16 (&o2)[2], int tid, int lane, Stage2& st) {
    const int n = kt_hi - kt_lo + 1;
    if (n <= 0) return;
    const int r = lane & 31, h = lane >> 5, nst = (n + 1) >> 1;
    const int skey = tid >> 3, sc = tid & 7;
#define ST2_LOAD(T0) do { const int t0_ = (T0), t1_ = (t0_ + 1 > kt_hi) ? kt_hi : t0_ + 1; \
        const size_t a0_ = (size_t)(64 * t0_ + skey) * pitch + 8 * sc, a1_ = (size_t)(64 * t1_ + skey) * pitch + 8 * sc; \
        st.k0 = *(const u32x4*)(Kg + a0_); st.v0 = *(const u32x4*)(Vg + a0_); st.k1 = *(const u32x4*)(Kg + a1_); st.v1 = *(const u32x4*)(Vg + a1_); } while (0)
#define ST2_STORE(BUF) do { LAS char* b_ = lds + (BUF) * 4 * TILE_B + skey * KP + 16 * sc; \
        *(LAS u32x4*)(b_) = st.k0; *(LAS u32x4*)(b_ + TILE_B) = st.v0; *(LAS u32x4*)(b_ + 2 * TILE_B) = st.k1; *(LAS u32x4*)(b_ + 3 * TILE_B) = st.v1; } while (0)
    if (!PRE) ST2_LOAD(kt_lo);
    ST2_STORE(0);
    __syncthreads();
    for (int sti = 0; sti < nst; ++sti) {
        if (sti + 1 < nst) ST2_LOAD(kt_lo + 2 * (sti + 1));
        if (MODE != MODE_DIFF) {
            const int kt0 = kt_lo + 2 * sti;
            bool both = (kt0 + 1 <= kt_hi) && (64 * kt0 + 127 <= q0w);
            if (MODE == MODE_NWIN) both = both && (64 * kt0 > q0w + 31 - 512);
            if (both) {
                bool ls0 = true, ls1 = true;
                if (MODE == MODE_MOBA) { ls0 = ((sel >> (kt0 >> 2)) & 1ull) != 0ull; ls1 = ((sel >> ((kt0 + 1) >> 2)) & 1ull) != 0ull; }
                if (MODE == MODE_NSEL) { ls0 = ((sel >> kt0) & 1ull) != 0ull; ls1 = ((sel >> (kt0 + 1)) & 1ull) != 0ull; }
                const unsigned long long b0 = __builtin_amdgcn_ballot_w64(ls0), b1 = __builtin_amdgcn_ballot_w64(ls1);
                if (b0 != 0ull && b1 != 0ull) {
                    LAS char* K0 = lds + (sti & 1) * 4 * TILE_B;
                    if ((b0 & b1) == ~0ull) tile128_pipe<0>(K0, K0 + TILE_B, K0 + 2 * TILE_B, K0 + 3 * TILE_B, qf, 1u, 1u, m1, l1, o1, r, h, lane);
                    else tile128_pipe<1>(K0, K0 + TILE_B, K0 + 2 * TILE_B, K0 + 3 * TILE_B, qf, ls0 ? 1u : 0u, ls1 ? 1u : 0u, m1, l1, o1, r, h, lane);
                    goto step_done;
                }
            }
        }
#pragma unroll 1
        for (int half = 0; half < 2; ++half) {
        const int kt = kt_lo + 2 * sti + half;
        if (kt > kt_hi) break;
        LAS char* Kl = lds + (sti & 1) * 4 * TILE_B + half * 2 * TILE_B; LAS char* Vl = Kl + TILE_B;
        bool full2 = (64 * kt + 63 <= q0w);
        if (MODE == MODE_NWIN) full2 = full2 && (64 * kt > q0w + 31 - 512);
        if (full2 && (MODE != MODE_DIFF || DIFF_MERGED)) {
            bool lsel = true;
            if (MODE == MODE_MOBA) lsel = ((sel >> (kt >> 2)) & 1ull) != 0ull;
            if (MODE == MODE_NSEL) lsel = ((sel >> kt) & 1ull) != 0ull;
            const unsigned long long selb = __builtin_amdgcn_ballot_w64(lsel);
            if (selb != 0ull) {
                const unsigned vm = lsel ? 1u : 0u; bf16x8 pf[4];
                if (MODE == MODE_DIFF) {
                    { const f32x16 sa = qk_rows<0, 2>(Kl, 0, qf, r, h), sb = qk_rows<0, 2>(Kl, 32, qf, r, h);
                      smax_step64<0>(sa, sb, vm, m1, l1, o1, pf, lane); __builtin_amdgcn_sched_barrier(0); pv_rows64(o1, Vl, pf, lane); }
                    __builtin_amdgcn_sched_barrier(0);
                    { const f32x16 sa = qk_rows<2, 4>(Kl, 0, qf, r, h), sb = qk_rows<2, 4>(Kl, 32, qf, r, h);
                      smax_step64<0>(sa, sb, vm, m2, l2, o2, pf, lane); __builtin_amdgcn_sched_barrier(0); pv_rows64(o2, Vl, pf, lane); }
                } else {
#if PIPE64
                    if (selb == ~0ull) tile64_pipe<0>(Kl, Vl, qf, vm, m1, l1, o1, r, h, lane); else tile64_pipe<1>(Kl, Vl, qf, vm, m1, l1, o1, r, h, lane);
#else
                    const f32x16 sa = qk_rows<0, 4>(Kl, 0, qf, r, h), sb = qk_rows<0, 4>(Kl, 32, qf, r, h);
                    if (selb == ~0ull) smax_step64<0>(sa, sb, vm, m1, l1, o1, pf, lane); else smax_step64<1>(sa, sb, vm, m1, l1, o1, pf, lane);
                    pv_rows64(o1, Vl, pf, lane);
#endif
                }
            }
        } else
#pragma unroll
        for (int sub = 0; sub < 2; ++sub) {
            const int kbase = 64 * kt + 32 * sub;
            if (kbase > q0w + 31) continue;
            if (MODE == MODE_NWIN && kbase + 31 <= q0w - 512) continue;
            bool full = (kbase + 31 <= q0w);
            if (MODE == MODE_NWIN) full = full && (kbase > q0w + 31 - 512);
            bool lsel = true;
            if (MODE == MODE_MOBA) lsel = ((sel >> (kbase >> 8)) & 1ull) != 0ull;
            if (MODE == MODE_NSEL) lsel = ((sel >> kt) & 1ull) != 0ull;
            const unsigned long long selb = __builtin_amdgcn_ballot_w64(lsel);
            if (selb == 0ull) continue;
            int mm; unsigned vm;
            if (full) { mm = (selb == ~0ull) ? 0 : 1; vm = lsel ? 1u : 0u; }
            else { mm = 2; vm = 0;
#pragma unroll
                for (int i = 0; i < 16; ++i) { const int kidx = kbase + (i & 3) + 8 * (i >> 2) + 4 * h; bool ok = kidx <= qpos; if (MODE == MODE_NWIN) ok = ok && (kidx > qpos - 512); vm |= ok ? (1u << i) : 0u; }
                if (!lsel) vm = 0;
                if (__builtin_amdgcn_ballot_w64(vm != 0) == 0ull) continue; }
            bf16x8 pf[2];
            if (MODE == MODE_DIFF) {
                const f32x16 s1 = qk_rows<0, 2>(Kl, 32 * sub, qf, r, h), s2 = qk_rows<2, 4>(Kl, 32 * sub, qf, r, h);
                bf16x8 pf2[2];
                if (mm == 0) { smax_step<0>(s1, vm, m1, l1, o1, pf, lane); smax_step<0>(s2, vm, m2, l2, o2, pf2, lane); }
                else { smax_step<2>(s1, vm, m1, l1, o1, pf, lane); smax_step<2>(s2, vm, m2, l2, o2, pf2, lane); }
                pv_rows(o1, Vl, 32 * sub, pf, lane);
                pv_rows(o2, Vl, 32 * sub, pf2, lane);
            } else {
                const f32x16 s = qk_rows<0, 4>(Kl, 32 * sub, qf, r, h);
                if (mm == 0) smax_step<0>(s, vm, m1, l1, o1, pf, lane); else if (mm == 1) smax_step<1>(s, vm, m1, l1, o1, pf, lane); else smax_step<2>(s, vm, m1, l1, o1, pf, lane);
                pv_rows(o1, Vl, 32 * sub, pf, lane);
            }
        }
        }
        step_done:
        if (sti + 1 < nst) ST2_STORE((sti + 1) & 1);
        __syncthreads();
    }
#undef ST2_LOAD
#undef ST2_STORE
}

DI void sb_unit(const Params& P, LAS char* lds, int b, int hd, int qb, int wave, int lane) {
    const bf16_t* hb = (const bf16_t*)(P.ws + WS_H);
    const int r = lane & 31, h = lane >> 5, q0w = 256 * qb + 32 * wave, qpos = q0w + r;
    bf16x8 qf[4]; load_q(qf, hb + (size_t)(b * SEQ + qpos) * NIN + C_SBQ + 64 * hd, h);
    const bf16_t* Kg = hb + (size_t)b * SEQ * NIN + C_SBK + 64 * hd; const bf16_t* Vg = hb + (size_t)b * SEQ * NIN + C_SBV + 64 * hd;
    LAS char* Kl = lds + wave * 9216; LAS char* Vl = Kl + 4608;
    f32x16 o[2]; zero_o(o);
    float carry = 0.f;
    for (int st = q0w >> 5; st >= 0; --st) {
        const int kbase = 32 * st;
        u32x4 kr[4], vr[4];
#pragma unroll
        for (int jj = 0; jj < 4; ++jj) { const int ch = lane + 64 * jj, key = ch >> 3, cc = ch & 7;
            kr[jj] = *(const u32x4*)(Kg + (size_t)(kbase + key) * NIN + 8 * cc); vr[jj] = *(const u32x4*)(Vg + (size_t)(kbase + key) * NIN + 8 * cc); }
        asm volatile("" ::: "memory");
#pragma unroll
        for (int jj = 0; jj < 4; ++jj) { const int ch = lane + 64 * jj, key = ch >> 3, cc = ch & 7;
            *(LAS u32x4*)(Kl + key * KP + 16 * cc) = kr[jj]; *(LAS u32x4*)(Vl + key * KP + 16 * cc) = vr[jj]; }
        LDS_WAIT(); asm volatile("" ::: "memory");
        const f32x16 s = qk_rows<0, 4>(Kl, 0, qf, r, h);
        float l1m[16], ls[16];
        unsigned vm = 0;
#pragma unroll
        for (int i = 0; i < 16; ++i) { const int kidx = kbase + (i & 3) + 8 * (i >> 2) + 4 * h; const bool ok = kidx < qpos; vm |= ok ? (1u << i) : 0u;
            const float z = s[i] * 0.125f; const float sp = fmaxf(z, 0.f) + __logf(1.0f + __expf(-fabsf(z)));
            l1m[i] = ok ? -sp : 0.f; ls[i] = z - sp; }
        float G[4], Gp[4], tot[4];
#pragma unroll
        for (int g = 0; g < 4; ++g) { G[g] = (l1m[4 * g] + l1m[4 * g + 1]) + (l1m[4 * g + 2] + l1m[4 * g + 3]); Gp[g] = shx32(G[g], lane); tot[g] = G[g] + Gp[g]; }
        float aft[4];
        aft[3] = (h == 0) ? Gp[3] : 0.f;
        aft[2] = tot[3] + ((h == 0) ? Gp[2] : 0.f);
        aft[1] = tot[3] + tot[2] + ((h == 0) ? Gp[1] : 0.f);
        aft[0] = tot[3] + tot[2] + tot[1] + ((h == 0) ? Gp[0] : 0.f);
        float p[16];
#pragma unroll
        for (int g = 0; g < 4; ++g) {
            const float base = carry + aft[g];
            const float w3 = 0.f, w2 = l1m[4 * g + 3], w1 = w2 + l1m[4 * g + 2], w0 = w1 + l1m[4 * g + 1];
            p[4 * g + 0] = ((vm >> (4 * g + 0)) & 1u) ? __expf(ls[4 * g + 0] + base + w0) : 0.f;
            p[4 * g + 1] = ((vm >> (4 * g + 1)) & 1u) ? __expf(ls[4 * g + 1] + base + w1) : 0.f;
            p[4 * g + 2] = ((vm >> (4 * g + 2)) & 1u) ? __expf(ls[4 * g + 2] + base + w2) : 0.f;
            p[4 * g + 3] = ((vm >> (4 * g + 3)) & 1u) ? __expf(ls[4 * g + 3] + base + w3) : 0.f;
        }
        carry += (tot[0] + tot[1]) + (tot[2] + tot[3]);
        bf16x8 pf[2]; pack_p(p, pf);
        pv_rows(o, Vl, 0, pf, lane);
        asm volatile("" ::: "memory");
        if (__builtin_amdgcn_ballot_w64(carry >= -120.0f) == 0ull) break;
    }
    store_o((bf16_t*)(P.ws + WS_O) + ((size_t)0 * TOK + (size_t)b * SEQ + qpos) * 256 + 64 * hd, o, h);
}

DI void diff_unit(const Params& P, int l, LAS char* lds, int b, int hd, int qb, int tid, int wave, int lane) {
    const bf16_t* hb = (const bf16_t*)(P.ws + WS_H);
    const int r = lane & 31, h = lane >> 5, q0w = 256 * qb + 32 * wave, qpos = q0w + r;
    bf16x8 qf[4]; load_q(qf, hb + (size_t)(b * SEQ + qpos) * NIN + C_DFQ + 64 * hd, h);
    Stage2 st0; flash_prefetch(st0, hb + (size_t)b * SEQ * NIN + C_DFK + 64 * hd, hb + (size_t)b * SEQ * NIN + C_DFV + 64 * hd, NIN, 0, 4 * qb + 3, tid);
    norm_rope_q<true>(qf, P.in[3] + (size_t)l * 32, 0.17677669529663687f * LOG2E, qpos & (SEQ - 1), h, lane);
    const bf16_t* Kg = hb + (size_t)b * SEQ * NIN + C_DFK + 64 * hd; const bf16_t* Vg = hb + (size_t)b * SEQ * NIN + C_DFV + 64 * hd;
    f32x16 o1[2], o2[2]; zero_o(o1); zero_o(o2);
    float m1 = -1e30f, l1 = 0.f, m2 = -1e30f, l2 = 0.f;
    flash_tiles<MODE_DIFF, true>(lds, Kg, Vg, NIN, 0, 4 * qb + 3, qf, qpos, q0w, 0ull, 1.0f, m1, l1, o1, m2, l2, o2, tid, lane, st0);
    const float* lp = P.in[5] + (size_t)l * 4 * 32;
    float s01 = (lane < 32) ? lp[lane] * lp[32 + lane] : 0.f, s23 = (lane < 32) ? lp[64 + lane] * lp[96 + lane] : 0.f;
    s01 = wave_sum(s01, lane); s23 = wave_sum(s23, lane);
    float lf = (float)l; asm volatile("" : "+v"(lf));
    const float lam_init = 0.8f - 0.6f * expf(-0.3f * lf);
    const float lam = expf(s01) - expf(s23) + lam_init;
    const float i1 = 1.0f / l1, i2 = lam / l2;
    float ss = 0.f;
#pragma unroll
    for (int dt = 0; dt < 2; ++dt)
#pragma unroll
        for (int i = 0; i < 16; ++i) { const float v = o1[dt][i] * i1 - o2[dt][i] * i2; o1[dt][i] = v; ss += v * v; }
    ss += shx32(ss, lane);
    const float rstd = (1.0f - lam_init) / sqrtf(ss * (1.0f / 64.0f) + RMS_EPS);
    const float* sg = P.in[6] + (size_t)l * 64;
#pragma unroll
    for (int dt = 0; dt < 2; ++dt)
#pragma unroll
        for (int i = 0; i < 16; ++i) o1[dt][i] = o1[dt][i] * rstd * sg[32 * dt + (i & 3) + 8 * (i >> 2) + 4 * h];
    store_o((bf16_t*)(P.ws + WS_O) + ((size_t)1 * TOK + (size_t)b * SEQ + qpos) * 256 + 64 * hd, o1, h);
}

DI void moba_unit(const Params& P, int l, LAS char* lds, int b, int hd, int qb, int tid, int wave, int lane) {
    const bf16_t* hb = (const bf16_t*)(P.ws + WS_H);
    const int r = lane & 31, h = lane >> 5, q0w = 256 * qb + 32 * wave, qpos = q0w + r;
    LAS float* kmL = (LAS float*)(lds + 8 * TILE_B);
    const float* kmg = (const float*)(P.ws + WS_KMEAN) + (size_t)(b * 4 + hd) * 16 * 4 * 64;
#pragma unroll
    for (int u = 0; u < 2; ++u) { const int e = tid + 512 * u, nb = e >> 6, d = e & 63; const float* q4 = kmg + (size_t)nb * 256 + d;
        kmL[e] = (((q4[0] + q4[64]) + q4[128]) + q4[192]) * (1.0f / 256.0f); }
    __syncthreads();
    bf16x8 qf[4]; load_q(qf, hb + (size_t)(b * SEQ + qpos) * NIN + C_MBQ + 64 * hd, h);
    Stage2 st0; flash_prefetch(st0, hb + (size_t)b * SEQ * NIN + C_MBK + 64 * hd, hb + (size_t)b * SEQ * NIN + C_MBV + 64 * hd, NIN, 0, 4 * qb + 3, tid);
    norm_rope_q<false>(qf, P.in[7] + (size_t)l * 64, 0.125f * LOG2E, qpos, h, lane);
    float qv[4][8];
#pragma unroll
    for (int ks = 0; ks < 4; ++ks) unpack8(__builtin_bit_cast(u32x4, qf[ks]), qv[ks]);
    float v0 = -3e38f, v1 = -3e38f, v2 = -3e38f; int i0 = -1, i1 = -1, i2 = -1;
#pragma unroll 1
    for (int n = 0; n < qb; ++n) {
        float g = 0.f;
#pragma unroll
        for (int ks = 0; ks < 4; ++ks) { const f32x4 a = *(LAS const f32x4*)(kmL + n * 64 + 16 * ks + 8 * h), bq = *(LAS const f32x4*)(kmL + n * 64 + 16 * ks + 8 * h + 4);
            g += (qv[ks][0] * a[0] + qv[ks][1] * a[1]) + (qv[ks][2] * a[2] + qv[ks][3] * a[3]) + (qv[ks][4] * bq[0] + qv[ks][5] * bq[1]) + (qv[ks][6] * bq[2] + qv[ks][7] * bq[3]); }
        g += shx32(g, lane);
        if (g > v0) { v2 = v1; i2 = i1; v1 = v0; i1 = i0; v0 = g; i0 = n; }
        else if (g > v1) { v2 = v1; i2 = i1; v1 = g; i1 = n; }
        else if (g > v2) { v2 = g; i2 = n; }
    }
    unsigned bm = 0;
    if (i0 >= 0) bm |= 1u << i0;
    if (i1 >= 0) bm |= 1u << i1;
    if (i2 >= 0) bm |= 1u << i2;
    bm |= 1u << qb;
    f32x16 o[2], od[2]; zero_o(o);
    float m = -1e30f, lsum = 0.f, md = 0.f, ld = 0.f;
    flash_tiles<MODE_MOBA, true>(lds, hb + (size_t)b * SEQ * NIN + C_MBK + 64 * hd, hb + (size_t)b * SEQ * NIN + C_MBV + 64 * hd, NIN, 0, 4 * qb + 3, qf, qpos, q0w,
                           (unsigned long long)bm, 1.0f, m, lsum, o, md, ld, od, tid, lane, st0);
    const float inv = 1.0f / lsum;
#pragma unroll
    for (int i = 0; i < 16; ++i) { o[0][i] *= inv; o[1][i] *= inv; }
    store_o((bf16_t*)(P.ws + WS_O) + ((size_t)2 * TOK + (size_t)b * SEQ + qpos) * 256 + 64 * hd, o, h);
}

constexpr int NSA_IMP = 73728, NSA_SELM = NSA_IMP + 65536;
DI void nsa_unit(const Params& P, int l, LAS char* lds, int b, int qt, int tid, int wave, int lane) {
    const bf16_t* hb = (const bf16_t*)(P.ws + WS_H);
    const int r = lane & 31, h = lane >> 5, hd = wave & 3, qh = wave >> 2, q0w = 64 * qt + 32 * qh, qpos = q0w + r;
    const bf16_t* hrow = hb + (size_t)(b * SEQ + qpos) * NIN;
    bf16x8 qf[4]; load_q(qf, hrow + C_NSQ + 64 * hd, h);
    norm_rope_q<false>(qf, P.in[9] + (size_t)l * 64, 0.125f * LOG2E, qpos, h, lane);
    const float g_c = sigmoidf_(bf2f(hrow[C_NSG + 0 + hd])), g_s = sigmoidf_(bf2f(hrow[C_NSG + 4 + hd])), g_w = sigmoidf_(bf2f(hrow[C_NSG + 8 + hd]));
    const float c = 1.0f;
    LAS char* kcL = lds; LAS char* vcL = lds + 256 * KP;
    LAS float* impH = (LAS float*)(lds + NSA_IMP);
    const int nst = ((4 * qt + 2) >> 5) + 1;
    {
        const bf16_t* kcg = (const bf16_t*)(P.ws + WS_KC) + (size_t)b * 256 * 64; const bf16_t* vcg = (const bf16_t*)(P.ws + WS_VC) + (size_t)b * 256 * 64;
        const int lim = 32 * nst * 8;
        u32x4 kk[4], vv[4];
#pragma unroll
        for (int it = 0; it < 4; ++it) { const int ch = tid + 512 * it; if (ch < lim) { kk[it] = *(const u32x4*)(kcg + (size_t)ch * 8); vv[it] = *(const u32x4*)(vcg + (size_t)ch * 8); } }
#pragma unroll
        for (int it = 0; it < 4; ++it) { const int ch = tid + 512 * it, key = ch >> 3, cc = ch & 7; if (ch < lim) { *(LAS u32x4*)(kcL + key * KP + 16 * cc) = kk[it]; *(LAS u32x4*)(vcL + key * KP + 16 * cc) = vv[it]; } }
    }
    __syncthreads();
    f32x16 otot[2], o[2]; zero_o(otot); zero_o(o);
    float m = -1e30f, lsum = 0.f;
    for (int st = 0; st < nst; ++st) {
        const f32x16 s = qk_rows<0, 4>(kcL, 32 * st, qf, r, h);
        float t[16], mx = -1e30f;
#pragma unroll
        for (int i = 0; i < 16; ++i) { const int n = 32 * st + (i & 3) + 8 * (i >> 2) + 4 * h; const bool ok = (16 * n + 31 <= qpos); t[i] = ok ? s[i] * c : -1e30f; mx = fmaxf(mx, t[i]); }
        mx = fmaxf(mx, shx32(mx, lane));
        const float mn = fmaxf(m, mx), alpha = ex2(m - mn);
        float rs = 0.f;
#pragma unroll
        for (int i = 0; i < 16; ++i) rs += (t[i] > -1e29f) ? ex2(t[i] - mn) : 0.f;
        rs += shx32(rs, lane);
        lsum = lsum * alpha + rs; m = mn;
    }
    const float linv = lsum > 0.f ? 1.0f / lsum : 0.f;
    float prevpc3 = 0.f;
    for (int st = 0; st < nst; ++st) {
        const f32x16 s = qk_rows<0, 4>(kcL, 32 * st, qf, r, h);
        float p[16];
#pragma unroll
        for (int i = 0; i < 16; ++i) { const int n = 32 * st + (i & 3) + 8 * (i >> 2) + 4 * h; const bool ok = (16 * n + 31 <= qpos); p[i] = ok ? ex2(s[i] * c - m) * linv : 0.f; }
        float pc[4];
#pragma unroll
        for (int g = 0; g < 4; ++g) pc[g] = shx32(p[4 * g + 3], lane);
#pragma unroll
        for (int g = 0; g < 4; ++g) {
            const float a = 2.0f * ((p[4 * g] + p[4 * g + 1]) + p[4 * g + 2]) + p[4 * g + 3];
            const float pred = (h == 1) ? pc[g] : (g > 0 ? pc[g > 0 ? g - 1 : 0] : prevpc3);
            impH[(hd * 64 + 32 * qh + r) * 64 + 8 * st + 2 * g + h] = a + pred;
        }
        prevpc3 = pc[3];
        bf16x8 pf[2]; pack_p(p, pf);
        pv_rows(o, vcL, 32 * st, pf, lane);
    }
#pragma unroll
    for (int i = 0; i < 16; ++i) { otot[0][i] = g_c * o[0][i]; otot[1][i] = g_c * o[1][i]; }
    __syncthreads();
    Stage2 stS; flash_prefetch(stS, hb + (size_t)b * SEQ * NIN + C_KS, hb + (size_t)b * SEQ * NIN + C_VS, NIN, 0, qt, tid);
    {
        LAS float* impS = (LAS float*)lds;
        LAS unsigned long long* selm = (LAS unsigned long long*)(lds + NSA_SELM);
        const int q = tid >> 3, s8 = tid & 7;
        if (qt <= 15) { if (s8 == 0) selm[q] = (2ull << qt) - 1ull; }
        else {
#pragma unroll
            for (int e = 0; e < 8; ++e) { const int J = 8 * s8 + e; impS[q * 65 + J] = ((impH[(0 * 64 + q) * 64 + J] + impH[(1 * 64 + q) * 64 + J]) + impH[(2 * 64 + q) * 64 + J]) + impH[(3 * 64 + q) * 64 + J]; }
            __syncthreads();
            unsigned bits = 0;
#pragma unroll
            for (int e = 0; e < 8; ++e) {
                const int J = 8 * s8 + e;
                if (J >= 1 && J <= qt - 2) {
                    const float v = impS[q * 65 + J]; int cnt = 0;
                    for (int J2 = 1; J2 <= qt - 2; ++J2) { const float v2 = impS[q * 65 + J2]; cnt += (v2 > v || (v2 == v && J2 < J)) ? 1 : 0; }
                    if (cnt < 13) bits |= 1u << e;
                }
            }
            unsigned lo = (s8 < 4) ? (bits << (8 * s8)) : 0u, hi = (s8 >= 4) ? (bits << (8 * (s8 - 4))) : 0u;
            lo |= shxu(lo, 1, lane); lo |= shxu(lo, 2, lane); lo |= shxu(lo, 4, lane);
            hi |= shxu(hi, 1, lane); hi |= shxu(hi, 2, lane); hi |= shxu(hi, 4, lane);
            if (s8 == 0) selm[q] = ((unsigned long long)hi << 32) | (unsigned long long)lo | 1ull | (1ull << (qt - 1)) | (1ull << qt);
        }
    }
    __syncthreads();
    const unsigned long long sel = ((LAS const unsigned long long*)(lds + NSA_SELM))[32 * qh + r];
    float md = 0.f, ld = 0.f; f32x16 od[2];
    LAS float* stash = (LAS float*)(lds + NSA_IMP) + wave * 2048 + lane;
#pragma unroll
    for (int i = 0; i < 16; ++i) { stash[i * 64] = otot[0][i]; stash[(16 + i) * 64] = otot[1][i]; }
    zero_o(o); m = -1e30f; lsum = 0.f;
    flash_tiles<MODE_NSEL, true>(lds, hb + (size_t)b * SEQ * NIN + C_KS, hb + (size_t)b * SEQ * NIN + C_VS, NIN, 0, qt, qf, qpos, q0w, sel, c, m, lsum, o, md, ld, od, tid, lane, stS);
    { const float f = g_s / lsum;
#pragma unroll
      for (int i = 0; i < 16; ++i) { stash[i * 64] += f * o[0][i]; stash[(16 + i) * 64] += f * o[1][i]; } }
    zero_o(o); m = -1e30f; lsum = 0.f;
    flash_tiles<MODE_NWIN>(lds, hb + (size_t)b * SEQ * NIN + C_KW, hb + (size_t)b * SEQ * NIN + C_VW, NIN, qt > 8 ? qt - 8 : 0, qt, qf, qpos, q0w, 0ull, c, m, lsum, o, md, ld, od, tid, lane, stS);
    { const float f = g_w / lsum;
#pragma unroll
      for (int i = 0; i < 16; ++i) { otot[0][i] = stash[i * 64] + f * o[0][i]; otot[1][i] = stash[(16 + i) * 64] + f * o[1][i]; } }
    store_o((bf16_t*)(P.ws + WS_O) + ((size_t)3 * TOK + (size_t)b * SEQ + qpos) * 256 + 64 * hd, otot, h);
}

#define UNIT_LOOP(BODY) _Pragma("unroll 1") for (int k = 0; k * G < 512; ++k) { const int j = k * G + ((k & 1) ? (G - 1 - cblk) : cblk); if (j >= 512) continue; __syncthreads(); \
    int tid_ = wave_s * 64 + fresh_lane(); const int tid = tid_, lane = tid & 63, wave = wave_s; (void)tid; \
    const int bh = j & 31, qb = 15 - (j >> 5), b = bh >> 2, hd = bh & 3; (void)qb; (void)b; (void)hd; BODY; }
DI void attn_phase(const Params& P, int l, LAS char* lds, int G, int cblk, const int wave_s) {
    if (PH_MASK & 16u) { UNIT_LOOP(nsa_unit(P, l, lds, j & 7, 63 - (j >> 3), tid, wave, lane)) }
    if (PH_MASK & 32u) { UNIT_LOOP(diff_unit(P, l, lds, b, hd, qb, tid, wave, lane)) }
    if (PH_MASK & 64u) { UNIT_LOOP(moba_unit(P, l, lds, b, hd, qb, tid, wave, lane)) }
    if (PH_MASK & 128u) { UNIT_LOOP(sb_unit(P, lds, b, hd, qb, wave, lane)) }
}
__global__ void __launch_bounds__(NWAVES * 64 LB2) fwd_kernel(Params P) {
    extern __shared__ __attribute__((aligned(16))) unsigned char lds_raw[];
    cg::grid_group grid = cg::this_grid();
    LAS unsigned char* lds = (LAS unsigned char*)lds_raw;
    const int G = gridDim.x, bx = blockIdx.x;
    const int wave_s = __builtin_amdgcn_readfirstlane((int)threadIdx.x >> 6);
    if (threadIdx.x < 16) ((LAS unsigned*)(lds + LDS_BYTES - 64))[threadIdx.x] = 0u;
    __syncthreads();
    const XcdBarrier xbar = xcd_barrier_post((unsigned*)P.ws, (volatile LAS unsigned*)(lds + LDS_BYTES - 64));
    const int vcu = (G % 8 == 0) ? (bx % 8) * (G / 8) + bx / 8 : bx;
    const int NGW = G * NWAVES;
#define FRESH_IDS() int tid_ = wave_s * 64 + fresh_lane(); const int tid = tid_, lane = tid & 63, wave = __builtin_amdgcn_readfirstlane(tid >> 6), gw = vcu * NWAVES + wave; (void)gw; (void)lane; (void)tid
    bf16_t* XN = (bf16_t*)(P.ws + WS_XN); bf16_t* HB = (bf16_t*)(P.ws + WS_H); bf16_t* OB = (bf16_t*)(P.ws + WS_O); bf16_t* TB = (bf16_t*)(P.ws + WS_T);
    bf16_t* MG = (bf16_t*)(P.ws + WS_O); float* X1 = (float*)(P.ws + WS_X1); bf16_t* AB = (bf16_t*)(P.ws + WS_A);

    { FRESH_IDS(); if (PH_MASK & 1u) prologue_phase(P, lds, gw, NGW, wave, lane); }
    { FRESH_IDS(); rms_phase(P.in[0], P.in[1], XN, gw, NGW, lane); }
    if (P.ws == nullptr) grid.sync();
    xcd_barrier(xbar, wave_s);
#ifdef PROBE_SYNC
#define GSYNC() do { xcd_barrier(xbar, wave_s); xcd_barrier(xbar, wave_s); xcd_barrier(xbar, wave_s); } while (0)
#else
#define GSYNC() xcd_barrier(xbar, wave_s)
#endif
#pragma unroll 1
    for (int l = 0; l < DEPTH; ++l) {
        const float* xin = (l == 0) ? P.in[0] : (const float*)P.out;
        unsigned char* wl = P.ws + WS_W + (size_t)l * WL_STRIDE;
        if (l > 0) { FRESH_IDS(); rms_phase(xin, P.in[1] + (size_t)l * DM, XN, gw, NGW, lane); GSYNC(); }
        {
            pg8::Gemm g{XN, (const bf16_t*)(wl + WL_IN), TOK, NIN, DM}; pg8::StaticOrder S; S.init(TOK, NIN, G, bx);
            pg8::EpiStore E{HB, NIN};
            if (((PH_MASK & 8u) != 0u) & ((GEMM_SEL & 1u) != 0u)) pg8::gemm_phase<pg8::EpiStore, pg8::StaticOrder, true, true>(lds, g, S, E, wave_s);
#ifdef PROBE_GEMM2
            __syncthreads();
            if (((PH_MASK & 8u) != 0u) & ((GEMM_SEL & 1u) != 0u)) pg8::gemm_phase<pg8::EpiStore, pg8::StaticOrder, true, true>(lds, g, S, E, wave_s);
#endif
        }
        GSYNC();
        if (PH_MASK & 2u) { FRESH_IDS(); prep_phase(P, l, lds, G, bx, gw, NGW, wave, lane); }
        GSYNC();
        if (PH_MASK & 4u) { attn_phase(P, l, (LAS char*)lds, G, bx, wave_s); }
#ifdef PROBE_ATTN2
        grid.sync(); attn_phase(P, l, (LAS char*)lds, G, bx, wave_s);
#endif
        GSYNC();
        {
            pg8::Gemm g{OB, (const bf16_t*)(wl + WL_B), 4 * TOK, 4096, 256}; pg8::DiagOrder S{G, bx};
            pg8::EpiT E{TB};
            if (((PH_MASK & 8u) != 0u) & ((GEMM_SEL & 2u) != 0u)) pg8::gemm_phase<pg8::EpiT, pg8::DiagOrder, true, true>(lds, g, S, E, wave_s);
#ifdef PROBE_GEMM2
            __syncthreads();
            if (((PH_MASK & 8u) != 0u) & ((GEMM_SEL & 2u) != 0u)) pg8::gemm_phase<pg8::EpiT, pg8::DiagOrder, true, true>(lds, g, S, E, wave_s);
#endif
        }
        GSYNC();
        {
            pg8::Gemm g{XN, (const bf16_t*)(wl + WL_G), TOK, 4096, DM}; pg8::StaticOrder S; S.init(TOK, 4096, G, bx);
            pg8::EpiMerge E{TB, P.in[14] + (size_t)l * 4 * DM, MG};
            if (((PH_MASK & 8u) != 0u) & ((GEMM_SEL & 4u) != 0u)) pg8::gemm_phase<pg8::EpiMerge, pg8::StaticOrder, true, true>(lds, g, S, E, wave_s);
#ifdef PROBE_GEMM2
            __syncthreads();
            if (((PH_MASK & 8u) != 0u) & ((GEMM_SEL & 4u) != 0u)) pg8::gemm_phase<pg8::EpiMerge, pg8::StaticOrder, true, true>(lds, g, S, E, wave_s);
#endif
        }
        GSYNC();
        {
            pg8::Gemm g{MG, (const bf16_t*)(wl + WL_O), TOK, DM, DM}; pg8::StaticOrder S; S.init(TOK, DM, G, bx);
            pg8::EpiResid E{xin, X1};
            if (((PH_MASK & 8u) != 0u) & ((GEMM_SEL & 8u) != 0u)) pg8::gemm_phase<pg8::EpiResid, pg8::StaticOrder, true, true>(lds, g, S, E, wave_s);
#ifdef PROBE_GEMM2
            __syncthreads();
            if (((PH_MASK & 8u) != 0u) & ((GEMM_SEL & 8u) != 0u)) pg8::gemm_phase<pg8::EpiResid, pg8::StaticOrder, true, true>(lds, g, S, E, wave_s);
#endif
        }
        GSYNC();
        { FRESH_IDS(); rms_phase(X1, P.in[17] + (size_t)l * DM, XN, gw, NGW, lane); }
        GSYNC();
        {
            pg8::Gemm g{XN, (const bf16_t*)(wl + WL_GU), TOK, NGU, DM}; pg8::StaticOrder S; S.init(TOK, NGU, G, bx);
            pg8::EpiSwiGLU E{AB};
            if (((PH_MASK & 8u) != 0u) & ((GEMM_SEL & 16u) != 0u)) pg8::gemm_phase<pg8::EpiSwiGLU, pg8::StaticOrder, true, true>(lds, g, S, E, wave_s);
#ifdef PROBE_GEMM2
            __syncthreads();
            if (((PH_MASK & 8u) != 0u) & ((GEMM_SEL & 16u) != 0u)) pg8::gemm_phase<pg8::EpiSwiGLU, pg8::StaticOrder, true, true>(lds, g, S, E, wave_s);
#endif
        }
        GSYNC();
        {
            pg8::Gemm g{AB, (const bf16_t*)(wl + WL_D), TOK, DM, FF}; pg8::StaticOrder S; S.init(TOK, DM, G, bx);
            pg8::EpiResid E{X1, P.out};
            if (((PH_MASK & 8u) != 0u) & ((GEMM_SEL & 32u) != 0u)) pg8::gemm_phase<pg8::EpiResid, pg8::StaticOrder, true, true>(lds, g, S, E, wave_s);
#ifdef PROBE_GEMM2
            __syncthreads();
            if (((PH_MASK & 8u) != 0u) & ((GEMM_SEL & 32u) != 0u)) pg8::gemm_phase<pg8::EpiResid, pg8::StaticOrder, true, true>(lds, g, S, E, wave_s);
#endif
        }
        if (l + 1 < DEPTH) GSYNC();
    }
}

extern "C" void kernel_launch(void* const* d_in, const int* in_sizes, int n_in, void* d_out, int out_size, void* d_ws, size_t ws_size, hipStream_t stream) {
    static int grid = 0;
    if (grid == 0) {
        if (n_in != 21 || ws_size < WS_END) { fprintf(stderr, "kernel_launch: unexpected n_in %d / ws %zu\n", n_in, ws_size); grid = -1; return; }
        int dev = 0, cus = 0, per_cu = 0;
        (void)hipGetDevice(&dev); (void)hipDeviceGetAttribute(&cus, hipDeviceAttributeMultiprocessorCount, dev);
        (void)hipFuncSetAttribute((const void*)fwd_kernel, hipFuncAttributeMaxDynamicSharedMemorySize, LDS_BYTES);
        (void)hipOccupancyMaxActiveBlocksPerMultiprocessor(&per_cu, (const void*)fwd_kernel, NWAVES * 64, LDS_BYTES);
        if (per_cu < 1) per_cu = 1;
        grid = cus * 1;
        (void)hipGetLastError();
    }
    if (grid < 0) return;
    if (hipMemsetAsync(d_ws, 0, 16384, stream) != hipSuccess) { fprintf(stderr, "kernel_launch: memset of the barrier words failed\n"); return; }
    Params p{};
    for (int i = 0; i < 21; ++i) p.in[i] = (const float*)d_in[i];
    p.out = (float*)d_out; p.ws = (unsigned char*)d_ws;
    void* args[] = {&p};
    hipError_t e = hipLaunchCooperativeKernel((const void*)fwd_kernel, dim3(grid), dim3(NWAVES * 64), args, LDS_BYTES, stream);
    if (e != hipSuccess) fprintf(stderr, "cooperative launch failed: %s (grid %d)\n", hipGetErrorString(e), grid);
}
```
